# Optimizing an MI355X kernel written in HIP

```python
import math
import jax, jax.numpy as jnp
from jax import lax
import numpy as np

D_MODEL = 1024
BATCH = 8
SEQ = 4096
DEPTH = 1

HG_HEADS = 4
HG_DK = 128
HG_DV = 128
HG_KEY = HG_HEADS * HG_DK
HG_WIDTH = HG_HEADS * HG_DV
HG_CHUNK = 64
DA_HEADS = 4
DA_HD = 64
DA_DV = 2 * DA_HD
DA_QK = DA_HEADS * 2 * DA_HD
DA_WIDTH = DA_HEADS * DA_DV
Q_BLOCK = 128
N_EXPERTS = 32
TOP_K = 4
D_FF = 1024
SWIGLU_LIMIT = 7.0
SWIGLU_ALPHA = 1.702
DN_ALPHA = (2.0 * DEPTH) ** 0.25
DN_BETA = (8.0 * DEPTH) ** -0.25
LN_EPS = 1e-5
NORM_EPS = 1e-6
IN_SIZES = (HG_KEY, HG_KEY, HG_WIDTH, HG_WIDTH, DA_QK, DA_QK, DA_WIDTH, D_MODEL, D_MODEL)
D_IN = sum(IN_SIZES)

kernel_name = "hybrid_hgrn2_diffattn_moe_deepnorm"


def layer_norm(x, g, b):
    xf = x.astype(jnp.float32)
    mu = jnp.mean(xf, axis=-1, keepdims=True)
    xc = xf - mu
    var = jnp.mean(xc * xc, axis=-1, keepdims=True)
    y = xc * lax.rsqrt(var + LN_EPS) * g.astype(jnp.float32) + b.astype(jnp.float32)
    return y.astype(x.dtype)


def head_rms_norm(o, g):
    ms = jnp.mean(o * o, axis=-1, keepdims=True)
    return o * lax.rsqrt(ms + NORM_EPS) * g.astype(jnp.float32)


def alibi_slopes(n):
    return jnp.asarray([2.0 ** (-8.0 * (h + 1) / n) for h in range(n)], dtype=jnp.float32)


def hgrn2_branch(q, f_logit, i, g, lb, norm_g):
    B, S, _ = q.shape
    nc = S // HG_CHUNK
    f32 = jnp.float32
    f = lb + (1.0 - lb) * jax.nn.sigmoid(f_logit.astype(f32))
    log_f = jnp.log(f)
    k = 1.0 - f
    qa = jax.nn.silu(q.astype(f32))
    v = i.astype(f32)

    def to_chunks(t, d):
        return t.reshape(B, nc, HG_CHUNK, HG_HEADS, d).transpose(1, 0, 3, 2, 4)

    qc, kc, lc = to_chunks(qa, HG_DK), to_chunks(k, HG_DK), to_chunks(log_f, HG_DK)
    vc = to_chunks(v, HG_DV)
    causal = jnp.tril(jnp.ones((HG_CHUNK, HG_CHUNK), dtype=bool))[None, None, :, :, None]

    def step(state, inp):
        q_, k_, v_, l_ = inp
        bcum = jnp.cumsum(l_, axis=2)
        o_inter = jnp.einsum('bhtk,bhkv->bhtv', q_ * jnp.exp(bcum), state)
        diff = bcum[:, :, :, None, :] - bcum[:, :, None, :, :]
        decay = jnp.exp(jnp.where(causal, diff, -jnp.inf))
        attn = jnp.einsum('bhtk,bhsk,bhtsk->bhts', q_, k_, decay)
        o_intra = jnp.einsum('bhts,bhsv->bhtv', attn, v_)
        b_last = bcum[:, :, -1:, :]
        k_dec = k_ * jnp.exp(b_last - bcum)
        new_state = jnp.exp(b_last[:, :, 0, :])[..., None] * state + jnp.einsum('bhsk,bhsv->bhkv', k_dec, v_)
        return new_state, o_inter + o_intra

    state0 = jnp.zeros((B, HG_HEADS, HG_DK, HG_DV), f32)
    _, o = lax.scan(step, state0, (qc, kc, vc, lc))
    o = o.transpose(1, 0, 3, 2, 4).reshape(B, S, HG_HEADS, HG_DV)
    o = head_rms_norm(o, norm_g).reshape(B, S, HG_WIDTH)
    o = o * jax.nn.sigmoid(g.astype(f32))
    return o.astype(q.dtype)


def diff_attention_branch(q, k, v, lam_params, lambda_init, norm_g):
    B, S, _ = q.shape
    nb = S // Q_BLOCK
    f32 = jnp.float32
    qh = q.reshape(B, S, DA_HEADS, 2, DA_HD).transpose(0, 2, 3, 1, 4) * (DA_HD ** -0.5)
    kh = k.reshape(B, S, DA_HEADS, 2, DA_HD).transpose(0, 2, 3, 1, 4)
    vh = v.reshape(B, S, DA_HEADS, DA_DV).transpose(0, 2, 1, 3)
    lp = lam_params.astype(f32)
    lam = jnp.exp(jnp.sum(lp[0] * lp[1])) - jnp.exp(jnp.sum(lp[2] * lp[3])) + lambda_init
    slopes = alibi_slopes(DA_HEADS)
    kpos = jnp.arange(S)
    qb = qh.reshape(B, DA_HEADS, 2, nb, Q_BLOCK, DA_HD).transpose(3, 0, 1, 2, 4, 5)

    def block(args):
        qblk, bi = args
        qpos = bi * Q_BLOCK + jnp.arange(Q_BLOCK)
        s = jnp.einsum('bhjqd,bhjkd->bhjqk', qblk, kh).astype(f32)
        dist = qpos[:, None] - kpos[None, :]
        bias = -slopes[:, None, None] * dist.astype(f32)
        s = jnp.where(dist >= 0, s + bias[None, :, None], -jnp.inf)
        p = jax.nn.softmax(s, axis=-1)
        a = p[:, :, 0] - lam * p[:, :, 1]
        return jnp.einsum('bhqk,bhkv->bhqv', a.astype(vh.dtype), vh)

    o = lax.map(block, (qb, jnp.arange(nb)))
    o = o.transpose(1, 0, 3, 2, 4).reshape(B, S, DA_HEADS, DA_DV).astype(f32)
    o = head_rms_norm(o, norm_g) * (1.0 - lambda_init)
    return o.reshape(B, S, DA_WIDTH).astype(q.dtype)


def moe_ffn(x, router_w, router_b, w_gate_up, b_gate_up, w_down, b_down):
    B, S, D = x.shape
    xt = x.reshape(B * S, D)
    logits = (xt @ router_w + router_b).astype(jnp.float32)
    top_vals, top_idx = lax.top_k(logits, TOP_K)
    top_w = jax.nn.softmax(top_vals, axis=-1)
    combine = jnp.sum(jax.nn.one_hot(top_idx, N_EXPERTS, dtype=jnp.float32) * top_w[..., None], axis=1)

    def expert_step(acc, params):
        wgu, bgu, wd, bd, cw = params
        h = xt @ wgu + bgu
        gate = jnp.minimum(h[:, 0::2], SWIGLU_LIMIT)
        up = jnp.clip(h[:, 1::2], -SWIGLU_LIMIT, SWIGLU_LIMIT)
        glu = gate * jax.nn.sigmoid(gate * SWIGLU_ALPHA)
        y = ((up + 1.0) * glu) @ wd + bd
        return acc + cw[:, None] * y.astype(jnp.float32), None

    acc0 = jnp.zeros((B * S, D), jnp.float32)
    acc, _ = lax.scan(expert_step, acc0, (w_gate_up, b_gate_up, w_down, b_down, combine.T))
    return acc.reshape(B, S, D).astype(x.dtype)


def setup_inputs(seed: int = 0) -> dict:
    key = jax.random.key(seed)
    ks = jax.random.split(key, 20)
    n = jax.random.normal
    f32 = jnp.float32
    return {
        "x": n(ks[0], (BATCH, SEQ, D_MODEL), f32),
        "w_in": n(ks[1], (DEPTH, D_MODEL, D_IN), f32) * D_MODEL ** -0.5,
        "hg_lb_logits": n(ks[2], (DEPTH + 1, HG_KEY), f32) * 0.5,
        "hg_norm_g": 1.0 + 0.02 * n(ks[3], (DEPTH, HG_HEADS, HG_DV), f32),
        "da_lambda": 0.1 * n(ks[4], (DEPTH, 4, DA_HD), f32),
        "da_norm_g": 1.0 + 0.02 * n(ks[5], (DEPTH, DA_HEADS, DA_DV), f32),
        "w_branch_a": n(ks[6], (DEPTH, HG_WIDTH, D_MODEL), f32) * HG_WIDTH ** -0.5,
        "w_branch_b": n(ks[7], (DEPTH, DA_WIDTH, D_MODEL), f32) * DA_WIDTH ** -0.5,
        "w_out": n(ks[8], (DEPTH, D_MODEL, D_MODEL), f32) * (D_MODEL ** -0.5) * DN_BETA,
        "ln1_g": 1.0 + 0.02 * n(ks[9], (DEPTH, D_MODEL), f32),
        "ln1_b": 0.02 * n(ks[10], (DEPTH, D_MODEL), f32),
        "router_w": n(ks[11], (DEPTH, D_MODEL, N_EXPERTS), f32) * D_MODEL ** -0.5,
        "router_b": 0.01 * n(ks[12], (DEPTH, N_EXPERTS), f32),
        "w_gate_up": n(ks[13], (DEPTH, N_EXPERTS, D_MODEL, 2 * D_FF), f32) * D_MODEL ** -0.5,
        "b_gate_up": 0.01 * n(ks[14], (DEPTH, N_EXPERTS, 2 * D_FF), f32),
        "w_down": n(ks[15], (DEPTH, N_EXPERTS, D_FF, D_MODEL), f32) * (D_FF ** -0.5) * DN_BETA,
        "b_down": 0.01 * n(ks[16], (DEPTH, N_EXPERTS, D_MODEL), f32),
        "ln2_g": 1.0 + 0.02 * n(ks[17], (DEPTH, D_MODEL), f32),
        "ln2_b": 0.02 * n(ks[18], (DEPTH, D_MODEL), f32),
    }


def reference(x, w_in, hg_lb_logits, hg_norm_g, da_lambda, da_norm_g, w_branch_a, w_branch_b,
              w_out, ln1_g, ln1_b, router_w, router_b, w_gate_up, b_gate_up, w_down, b_down,
              ln2_g, ln2_b):
    split_points = [int(s) for s in np.cumsum(IN_SIZES)[:-1]]
    lb_all = jnp.cumsum(jax.nn.softmax(hg_lb_logits.astype(jnp.float32), axis=0), axis=0)
    h = x
    for l in range(DEPTH):
        lambda_init = 0.8 - 0.6 * math.exp(-0.3 * l)
        proj = h @ w_in[l]
        hq, hf, hi, hg, dq, dk, dv, ga, gb = jnp.split(proj, split_points, axis=-1)
        o_a = hgrn2_branch(hq, hf, hi, hg, lb_all[l], hg_norm_g[l])
        o_b = diff_attention_branch(dq, dk, dv, da_lambda[l], lambda_init, da_norm_g[l])
        merged = jax.nn.sigmoid(ga) * (o_a @ w_branch_a[l]) + jax.nn.sigmoid(gb) * (o_b @ w_branch_b[l])
        mix = merged @ w_out[l]
        h = layer_norm(DN_ALPHA * h + mix, ln1_g[l], ln1_b[l])
        ffn = moe_ffn(h, router_w[l], router_b[l], w_gate_up[l], b_gate_up[l], w_down[l], b_down[l])
        h = layer_norm(DN_ALPHA * h + ffn, ln2_g[l], ln2_b[l])
    return h
```

```cpp
#include <hip/hip_runtime.h>
#include <stdint.h>
#include <math.h>

#define DEVINL __device__ __forceinline__
typedef unsigned short bf16_t;
typedef short bf16x8 __attribute__((ext_vector_type(8)));
typedef float f32x4 __attribute__((ext_vector_type(4)));

constexpr int NTOK = 32768, DM = 1024, SEQ = 4096;
constexpr int DIN = 5632;
constexpr int NEXP = 32, DFF = 1024;
constexpr float DN_ALPHA = 1.189207115002721f;
constexpr float LAMBDA_INIT = 0.2f;

constexpr size_t MiB = 1ull << 20;
constexpr size_t OFF_QA = 0 * MiB, OFF_LF = 32 * MiB, OFF_HV = 96 * MiB, OFF_HG = 128 * MiB, OFF_DQ = 160 * MiB, OFF_DK = 192 * MiB, OFF_DV = 224 * MiB,
                 OFF_GA = 256 * MiB, OFF_GB = 320 * MiB, OFF_XB = 384 * MiB, OFF_U = 448 * MiB, OFF_OA = 480 * MiB, OFF_OJ = 512 * MiB, OFF_OB = 576 * MiB,
                 OFF_MERGED = 608 * MiB, OFF_WGU = 672 * MiB, OFF_WD = 800 * MiB, OFF_WIN = 864 * MiB, OFF_WA = 875 * MiB, OFF_WB = 876 * MiB, OFF_WOUT = 877 * MiB,
                 OFF_H1 = 879 * MiB, OFF_LTOK = 1007 * MiB, OFF_LW = 1011 * MiB, OFF_TOKE = 1015 * MiB, OFF_TOKR = 1015 * MiB + 512 * 1024, OFF_SMALL = 1016 * MiB,
                 WS_NEED = 1017 * MiB;
constexpr size_t OFF_XB8 = 448 * MiB  , OFF_WIN8 = 870 * MiB  ;
constexpr size_t OFF_Y1 = 0, OFF_Y2 = 0, OFF_H1B = 272 * MiB, OFF_ACT = 384 * MiB, OFF_OARAW = 879 * MiB;
constexpr size_t SMALL_CNT = 4096;

DEVINL float bf2f(bf16_t v) { return __uint_as_float(((unsigned)v) << 16); }
DEVINL bf16_t f2bf(float f) { unsigned u = __float_as_uint(f); return (bf16_t)((u + 0x7fffu + ((u >> 16) & 1u)) >> 16); }
DEVINL float sigmoidf_(float x) { return 1.0f / (1.0f + expf(-x)); }
DEVINL float wave_sum(float v) { for (int m = 32; m >= 1; m >>= 1) v += __shfl_xor(v, m); return v; }

namespace pg8 {
#define PG8_LAS __attribute__((address_space(3)))
typedef unsigned u32x4 __attribute__((ext_vector_type(4)));
typedef unsigned u32x2 __attribute__((ext_vector_type(2)));
typedef float f32x2 __attribute__((ext_vector_type(2)));
constexpr int BM = 256, BK = 64, HALF = 128, HTB = HALF * BK * 2, STAGE_BYTES = 8 * HTB, NXCD = 8, WGM = 8;
__host__ __device__ __forceinline__ int lds_byte(int r, int c) { const int st = (r >> 4) * 2 + (c >> 5), rr = r & 15, cc = c & 31, ob = rr * 64 + cc * 2; return st * 1024 + (ob ^ (((ob >> 9) & 1) << 5)); }
__host__ __device__ __forceinline__ void stage_rc(int b, int& R, int& C) { const int st = b / 1024, sb = b % 1024, swz = sb ^ (((sb >> 9) & 1) << 5); R = (st >> 1) * 16 + swz / 64; C = (st & 1) * 32 + (swz % 64) / 2; }
__host__ __device__ __forceinline__ int perm32(int rho) { const int n = rho >> 4, i = rho & 15; return 8 * (i >> 2) + 4 * n + (i & 3); }
typedef float f32x2_t __attribute__((ext_vector_type(2))); typedef __bf16 bf16x2_t __attribute__((ext_vector_type(2)));
__device__ __forceinline__ unsigned cvt_pk_bf16(float lo, float hi) { f32x2_t v = {lo, hi}; bf16x2_t b = __builtin_convertvector(v, bf16x2_t); return __builtin_bit_cast(unsigned, b); }

struct Unit { int pm, pn, e, r0; };

template <int WGMT = WGM> __device__ __forceinline__ void order_decode(long L, int nM, int nN, int& pm, int& pn) {
    const int nwg = nM * nN; int wgid = (int)L;
    { const int q = nwg / NXCD, r = nwg % NXCD, xcd = wgid % NXCD, off = wgid / NXCD; wgid = (xcd < r ? xcd * (q + 1) : r * (q + 1) + (xcd - r) * q) + off; }
    const int nig = WGMT * nN, gid = wgid / nig, fm = gid * WGMT, gsz = (nM - fm) < WGMT ? (nM - fm) : WGMT;
    pm = fm + ((wgid % nig) % gsz); pn = (wgid % nig) / gsz;
}
template <int K> struct PlainOrder {
    const char* A; const char* Bt; int nM, nN, G, c;
    __device__ __forceinline__ bool next(int i, Unit& u) const { const long L = (long)i * G + c; if (L >= (long)nM * nN) return false; order_decode(L, nM, nN, u.pm, u.pn); u.e = 0; u.r0 = 0; return true; }
    __device__ __forceinline__ const char* a_base(const Unit& u) const { return A + (size_t)u.pm * (256 * K * 2); }
    __device__ __forceinline__ const char* b_base(const Unit& u) const { return Bt + (size_t)u.pn * (256 * K * 2); }
    __device__ __forceinline__ void a_offsets(const Unit&, const int (&Rl)[2], const int (&Cl)[2], unsigned (&off)[2][2]) const {
#pragma unroll
        for (int h = 0; h < 2; ++h)
#pragma unroll
            for (int i = 0; i < 2; ++i) off[h][i] = (unsigned)((h * HALF + Rl[i]) * K + Cl[i]) * 2u;
    }
};

typedef int i32x4v __attribute__((ext_vector_type(4))); typedef int i32x8v __attribute__((ext_vector_type(8)));
template <class E> struct EpiWide { static constexpr bool value = false; };
template <class E> struct EpiWide2 { static constexpr bool value = false; };
template <class E> struct EpiChain { static constexpr bool value = false; };
template <bool F8> struct OperandT;
template <> struct OperandT<false> { struct type { bf16x8 k0, k1; };
    static __device__ __forceinline__ void load(type& d, PG8_LAS const unsigned char* p) { d.k0 = *(const PG8_LAS bf16x8*)p; d.k1 = *(const PG8_LAS bf16x8*)(p + 1024); }
    static __device__ __forceinline__ f32x4 mma(const type& b, const type& a, f32x4 c) { c = __builtin_amdgcn_mfma_f32_16x16x32_bf16(b.k0, a.k0, c, 0, 0, 0); return __builtin_amdgcn_mfma_f32_16x16x32_bf16(b.k1, a.k1, c, 0, 0, 0); }
    static __device__ __forceinline__ f32x4 mma0(const type& b, const type& a, f32x4 c) {
        asm volatile("v_mfma_f32_16x16x32_bf16 %0, %1, %2, 0\n\tv_mfma_f32_16x16x32_bf16 %0, %3, %4, %0" : "+v"(c) : "v"(b.k0), "v"(a.k0), "v"(b.k1), "v"(a.k1)); return c; } };
template <> struct OperandT<true> { typedef i32x8v type;
    static __device__ __forceinline__ void load(type& d, PG8_LAS const unsigned char* p) { const i32x4v lo = *(const PG8_LAS i32x4v*)p, hi = *(const PG8_LAS i32x4v*)(p + 1024); d = __builtin_shufflevector(lo, hi, 0, 1, 2, 3, 4, 5, 6, 7); }
    static __device__ __forceinline__ f32x4 mma(const type& b, const type& a, f32x4 c) { const int sc = 0x7f7f7f7f;
        asm volatile("v_mfma_scale_f32_16x16x128_f8f6f4 %0, %1, %2, %0, %3, %3 op_sel_hi:[0,0,0]" : "+v"(c) : "v"(b), "v"(a), "v"(sc)); return c; }
    static __device__ __forceinline__ f32x4 mma0(const type& b, const type& a, f32x4 c) { const int sc = 0x7f7f7f7f;
        asm volatile("v_mfma_scale_f32_16x16x128_f8f6f4 %0, %1, %2, 0, %3, %3 op_sel_hi:[0,0,0]" : "+v"(c) : "v"(b), "v"(a), "v"(sc)); return c; } };
template <int K, bool GATHER, class Epi, class Sched, bool F8 = false>
__device__ __forceinline__ void gemm_phase(PG8_LAS unsigned char* lds, const Sched& S, const Epi& E) {
    int tid_ = threadIdx.x; asm volatile("" : "+v"(tid_));
    const int tid = tid_, wid = __builtin_amdgcn_readfirstlane(tid >> 6), lane = tid & 63, wr = wid >> 2, wc = wid & 3, fr = lane & 15, fq = lane >> 4;
    constexpr int nt = K / BK;
    int Rl[2], Cl[2]; unsigned voffB[2][2];
#pragma unroll
    for (int i = 0; i < 2; ++i) { int R, C; stage_rc(tid * 16 + i * 8192, R, C); Rl[i] = R; Cl[i] = C;
#pragma unroll
        for (int h = 0; h < 2; ++h) { int Rb;
            if (EpiWide2<Epi>::value) Rb = 64 * (R >> 5) + 32 * h + 8 * ((R & 15) >> 2) + 4 * ((R >> 4) & 1) + (R & 3);
            else if (EpiWide<Epi>::value) Rb = 64 * (R >> 5) + 16 * ((R & 15) >> 2) + 8 * h + 4 * ((R >> 4) & 1) + (R & 3);
            else Rb = h * HALF + (Epi::PERM ? ((R & ~31) + perm32(R & 31)) : R);
            voffB[h][i] = (unsigned)(Rb * K + C) * 2u; } }
    unsigned voffA[2][2], voffAn[2][2];
    constexpr size_t kstep = (size_t)(BK * 2);
    constexpr size_t hstep = (size_t)HALF * K * 2;
    const unsigned ldsw = (unsigned)wid * 1024u;
    const int aoff = lds_byte(wr * 64 + fr, fq * 8), boff = lds_byte(wc * 32 + fr, fq * 8);
#define PG8_SA(b, h) (((b) * 2 + (h)) * HTB)
#define PG8_SB(b, h) ((4 + (b) * 2 + (h)) * HTB)
#define PG8_STAGE(bufoff, gbase, voff) do { _Pragma("unroll") for (int _i = 0; _i < 2; ++_i) \
        __builtin_amdgcn_global_load_lds((const unsigned*)((const char*)(gbase) + (voff)[_i]), (PG8_LAS unsigned*)(lds + (bufoff) + ldsw + _i * 8192), 16, 0, 0); } while (0)
#define PG8_LDA(dst, b, h) do { _Pragma("unroll") for (int m = 0; m < 4; ++m) OperandT<F8>::load(dst[m], lds + PG8_SA(b, h) + aoff + m * 2048); } while (0)
#define PG8_LDB(dst, b, h) do { _Pragma("unroll") for (int n = 0; n < 2; ++n) OperandT<F8>::load(dst[n], lds + PG8_SB(b, h) + boff + n * 2048); } while (0)
#define PG8_MMA(ai, bj, At, Bt) do { __builtin_amdgcn_s_setprio(1); _Pragma("unroll") for (int m = 0; m < 4; ++m) { \
        acc8[ai][bj][m].lo = OperandT<F8>::mma(Bt[0], At[m], acc8[ai][bj][m].lo); acc8[ai][bj][m].hi = OperandT<F8>::mma(Bt[1], At[m], acc8[ai][bj][m].hi); } __builtin_amdgcn_s_setprio(0); } while (0)
#define PG8_MMAZ(ai, bj, At, Bt) do { __builtin_amdgcn_s_setprio(1); _Pragma("unroll") for (int m = 0; m < 4; ++m) { \
        acc8[ai][bj][m].lo = OperandT<F8>::mma0(Bt[0], At[m], acc8[ai][bj][m].lo); acc8[ai][bj][m].hi = OperandT<F8>::mma0(Bt[1], At[m], acc8[ai][bj][m].hi); } __builtin_amdgcn_s_setprio(0); } while (0)
#define PG8_WAIT_V(n) asm volatile("s_waitcnt vmcnt(" #n ")" ::: "memory")
#define PG8_WAIT_L(n) asm volatile("s_waitcnt lgkmcnt(" #n ")" ::: "memory")
#define PG8_BAR __builtin_amdgcn_s_barrier()
#define PG8_SCHED __builtin_amdgcn_sched_barrier(0)
    Unit cur, nxt; int ui = 0;
    if (!S.next(0, cur)) return;
    typedef float f32x8v __attribute__((ext_vector_type(8)));
    f32x8v acc8[2][2][4];
#pragma unroll
    for (int a = 0; a < 2; ++a)
#pragma unroll
        for (int b = 0; b < 2; ++b)
#pragma unroll
            for (int m = 0; m < 4; ++m) acc8[a][b][m] = (f32x8v){0.f, 0.f, 0.f, 0.f, 0.f, 0.f, 0.f, 0.f};
    typename OperandT<F8>::type At[4], B0[2], B1[2];
    const char* cA = S.a_base(cur); const char* cB = S.b_base(cur);
    S.a_offsets(cur, Rl, Cl, voffA);
    PG8_STAGE(PG8_SB(0, 0), cB, voffB[0]); PG8_STAGE(PG8_SB(0, 1), cB, voffB[1]); PG8_STAGE(PG8_SA(0, 0), cA, voffA[0]); PG8_STAGE(PG8_SA(0, 1), cA, voffA[1]);
    if (wr == 1) PG8_BAR;
    PG8_WAIT_V(2); PG8_BAR;
    PG8_STAGE(PG8_SB(1, 0), cB + kstep, voffB[0]); PG8_STAGE(PG8_SA(1, 0), cA + kstep, voffA[0]); PG8_STAGE(PG8_SB(1, 1), cB + kstep, voffB[1]);
    PG8_WAIT_V(6); PG8_BAR;
    bool chain_mid = false;
    for (;;) {
        const bool has_next = S.next(ui + 1, nxt);
        const char* nA = has_next ? S.a_base(nxt) : cA; const char* nB = has_next ? S.b_base(nxt) : cB;
        if (GATHER) {
            if (has_next) S.a_offsets(nxt, Rl, Cl, voffAn);
            else {
#pragma unroll
                for (int h = 0; h < 2; ++h)
#pragma unroll
                    for (int i = 0; i < 2; ++i) voffAn[h][i] = voffA[h][i];
            }
        }
#define PG8_KITER(MM0) { \
            const bool last = (t == nt - 2); \
            const char* a1 = cA + (size_t)(t + 1) * kstep; \
            const char* a2 = last ? nA : cA + (size_t)(t + 2) * kstep; const char* b2 = last ? nB : cB + (size_t)(t + 2) * kstep; \
            const char* a3 = a2 + kstep; const char* b3 = b2 + kstep; \
            unsigned o2[2][2]; \
_Pragma("unroll") \
            for (int h = 0; h < 2; ++h) \
_Pragma("unroll") \
                for (int i = 0; i < 2; ++i) o2[h][i] = (GATHER && last) ? voffAn[h][i] : voffA[h][i]; \
            PG8_LDB(B0, 0, 0); PG8_LDB(B1, 0, 1); PG8_SCHED; PG8_LDA(At, 0, 0); PG8_STAGE(PG8_SA(1, 1), a1, voffA[1]); \
            PG8_WAIT_V(8); PG8_WAIT_L(0); PG8_BAR; MM0(0, 0, At, B0); MM0(0, 1, At, B1); PG8_BAR; PG8_SCHED; \
            PG8_LDA(At, 0, 1); PG8_STAGE(PG8_SB(0, 0), b2, voffB[0]); PG8_STAGE(PG8_SB(0, 1), b2, voffB[1]); PG8_STAGE(PG8_SA(0, 0), a2, o2[0]); \
            PG8_WAIT_V(8); PG8_WAIT_L(0); PG8_BAR; MM0(1, 0, At, B0); MM0(1, 1, At, B1); PG8_BAR; PG8_SCHED; \
            PG8_LDB(B0, 1, 0); PG8_LDB(B1, 1, 1); PG8_SCHED; PG8_LDA(At, 1, 0); PG8_STAGE(PG8_SA(0, 1), a2, o2[1]); \
            PG8_WAIT_V(8); PG8_WAIT_L(0); PG8_BAR; PG8_MMA(0, 0, At, B0); PG8_MMA(0, 1, At, B1); PG8_BAR; PG8_SCHED; \
            PG8_LDA(At, 1, 1); PG8_STAGE(PG8_SB(1, 0), b3, voffB[0]); PG8_STAGE(PG8_SB(1, 1), b3, voffB[1]); PG8_STAGE(PG8_SA(1, 0), a3, o2[0]); \
            PG8_WAIT_V(8); PG8_WAIT_L(0); PG8_BAR; PG8_MMA(1, 0, At, B0); PG8_MMA(1, 1, At, B1); PG8_BAR; PG8_SCHED; }
        { const int t = 0;
          if constexpr (EpiChain<Epi>::value) {
              if (!chain_mid) {
#pragma unroll
                  for (int a = 0; a < 2; ++a)
#pragma unroll
                      for (int b = 0; b < 2; ++b)
#pragma unroll
                          for (int m = 0; m < 4; ++m) acc8[a][b][m] = (f32x8v){0.f, 0.f, 0.f, 0.f, 0.f, 0.f, 0.f, 0.f};
              }
              PG8_KITER(PG8_MMA)
          } else PG8_KITER(PG8_MMAZ) }
#pragma unroll 1
        for (int t = 2; t < nt; t += 2) PG8_KITER(PG8_MMA)
#undef PG8_KITER
        if (wr == 0) PG8_BAR;
        if (F8) asm volatile("s_nop 15\n\ts_nop 15" ::: "memory");
        { Unit ecur; ecur.pm = __builtin_amdgcn_readfirstlane(cur.pm); ecur.pn = __builtin_amdgcn_readfirstlane(cur.pn); ecur.e = __builtin_amdgcn_readfirstlane(cur.e); ecur.r0 = __builtin_amdgcn_readfirstlane(cur.r0);
          asm volatile("" : "+s"(ecur.pm), "+s"(ecur.pn), "+s"(ecur.e), "+s"(ecur.r0));
          int efr = fr, efq = fq; asm volatile("" : "+v"(efr), "+v"(efq));
          f32x4 acc[2][2][4][2];
#pragma unroll
          for (int a = 0; a < 2; ++a)
#pragma unroll
              for (int b = 0; b < 2; ++b)
#pragma unroll
                  for (int m = 0; m < 4; ++m) { acc[a][b][m][0] = acc8[a][b][m].lo; acc[a][b][m][1] = acc8[a][b][m].hi; }
          if constexpr (EpiChain<Epi>::value) {
              chain_mid = S.is_mid(ecur);
              if (chain_mid) { E.mid(acc, ecur, wr, wc, efr, efq);
#pragma unroll
                  for (int a = 0; a < 2; ++a)
#pragma unroll
                      for (int b = 0; b < 2; ++b)
#pragma unroll
                          for (int m = 0; m < 4; ++m) { acc8[a][b][m].lo = acc[a][b][m][0]; acc8[a][b][m].hi = acc[a][b][m][1]; } }
              else E(acc, ecur, wr, wc, efr, efq);
          } else E(acc, ecur, wr, wc, efr, efq); }
        if (!has_next) break;
        cur = nxt; cA = nA; cB = nB; ++ui;
        if (GATHER) {
#pragma unroll
            for (int h = 0; h < 2; ++h)
#pragma unroll
                for (int i = 0; i < 2; ++i) voffA[h][i] = voffAn[h][i];
        }
        if (wr == 1) PG8_BAR;
    }
    PG8_WAIT_V(0);
    PG8_BAR;
#undef PG8_SA
#undef PG8_SB
#undef PG8_STAGE
#undef PG8_LDA
#undef PG8_LDB
#undef PG8_MMA
#undef PG8_MMAZ
#undef PG8_WAIT_V
#undef PG8_WAIT_L
#undef PG8_BAR
#undef PG8_SCHED
}
}

DEVINL int opaque_tid() { int t = threadIdx.x; asm volatile("" : "+v"(t)); return t; }
DEVINL unsigned pk4_fp8(float a, float b, float c, float d) { int w = __builtin_amdgcn_cvt_pk_fp8_f32(a, b, 0, false); w = __builtin_amdgcn_cvt_pk_fp8_f32(c, d, w, true); return (unsigned)w; }
DEVINL float fsig(float v) { return __builtin_amdgcn_rcpf(1.0f + __expf(-v)); }
using pg8::Unit; using pg8::u32x4; using pg8::cvt_pk_bf16;

template <int MODE> DEVINL float act_mode(float v) { if (MODE == 0) return v * fsig(v); if (MODE == 3) return fsig(v); if (MODE == 4) return v * 0.18033688011112042f; return v; }
template <int MODE> DEVINL void store_bf16_tile(const f32x4 (&acc)[2][2][4][2], bf16_t* base, int pitch, int row0, int col0, float sc) {
#pragma unroll
    for (int ai = 0; ai < 2; ++ai)
#pragma unroll
        for (int m = 0; m < 4; ++m) { bf16_t* rowp = base + (size_t)(row0 + ai * 128 + m * 16) * pitch + col0;
#pragma unroll
            for (int bj = 0; bj < 2; ++bj) { const f32x4 v0 = acc[ai][bj][m][0] * sc, v1 = acc[ai][bj][m][1] * sc; u32x4 w;
                w.x = cvt_pk_bf16(act_mode<MODE>(v0[0]), act_mode<MODE>(v0[1])); w.y = cvt_pk_bf16(act_mode<MODE>(v0[2]), act_mode<MODE>(v0[3]));
                w.z = cvt_pk_bf16(act_mode<MODE>(v1[0]), act_mode<MODE>(v1[1])); w.w = cvt_pk_bf16(act_mode<MODE>(v1[2]), act_mode<MODE>(v1[3]));
                *(u32x4*)(rowp + bj * 32) = w; } }
}
template <bool F8> struct EpiInproj {
    static constexpr bool PERM = true; static constexpr int NVM = 0;
    unsigned char* ws; const float* lb;
    DEVINL void operator()(const f32x4 (&acc)[2][2][4][2], const Unit& u, int wr, int wc, int fr, int fq) const {
        const int sidx = u.pn >> 1; const int seg = F8 ? (sidx == 0 ? 3 : 6 + sidx) : (sidx < 3 ? sidx : sidx + 1);
        const int row0 = u.pm * 256 + wr * 64 + fr; const int cseg = (u.pn & 1) * 256 + wc * 64 + 8 * fq;
        const float sc = F8 ? (1.0f / 32.0f) : 1.0f;
        if (!F8 && seg == 1) {
            _Float16* base = (_Float16*)(ws + OFF_LF);
            f32x4 lbv[2][2];
#pragma unroll
            for (int bj = 0; bj < 2; ++bj)
#pragma unroll
                for (int n = 0; n < 2; ++n) lbv[bj][n] = *(const f32x4*)(lb + cseg + 32 * bj + 4 * n);
#pragma unroll
            for (int ai = 0; ai < 2; ++ai)
#pragma unroll
                for (int m = 0; m < 4; ++m) { _Float16* rowp = base + (size_t)(row0 + ai * 128 + m * 16) * 512 + cseg;
#pragma unroll
                    for (int bj = 0; bj < 2; ++bj) { typedef _Float16 h8_t __attribute__((ext_vector_type(8))); h8_t o;
#pragma unroll
                        for (int n = 0; n < 2; ++n) { const f32x4 v = acc[ai][bj][m][n]; const f32x4 l = lbv[bj][n];
#pragma unroll
                            for (int j = 0; j < 4; ++j) o[4 * n + j] = (_Float16)__logf(l[j] + (1.0f - l[j]) * fsig(v[j])); }
                        *(h8_t*)(rowp + bj * 32) = o; } }
        } else if (!F8 && seg == 0) store_bf16_tile<0>(acc, (bf16_t*)(ws + OFF_QA), 512, row0, cseg, sc);
        else if (!F8 && seg == 2) store_bf16_tile<2>(acc, (bf16_t*)(ws + OFF_HV), 512, row0, cseg, sc);
        else if (!F8 && seg == 4) store_bf16_tile<4>(acc, (bf16_t*)(ws + OFF_DQ), 512, row0, cseg, sc);
        else if (!F8 && seg == 5) store_bf16_tile<2>(acc, (bf16_t*)(ws + OFF_DK), 512, row0, cseg, sc);
        else if (!F8 && seg == 6) store_bf16_tile<2>(acc, (bf16_t*)(ws + OFF_DV), 512, row0, cseg, sc);
        else if (F8 && seg == 3) store_bf16_tile<3>(acc, (bf16_t*)(ws + OFF_HG), 512, row0, cseg, sc);
        else if (F8 && seg < 9) store_bf16_tile<3>(acc, (bf16_t*)(ws + OFF_GA), 1024, row0, (seg - 7) * 512 + cseg, sc);
        else if (F8) store_bf16_tile<3>(acc, (bf16_t*)(ws + OFF_GB), 1024, row0, (seg - 9) * 512 + cseg, sc);
    }
};
template <> struct pg8::EpiWide2<EpiInproj<false>> { static constexpr bool value = true; };
template <> struct pg8::EpiWide2<EpiInproj<true>> { static constexpr bool value = true; };
DEVINL f32x4 bf4_lo(const u32x4 w) { return (f32x4){__uint_as_float(w.x << 16), __uint_as_float(w.x & 0xffff0000u), __uint_as_float(w.y << 16), __uint_as_float(w.y & 0xffff0000u)}; }
DEVINL f32x4 bf4_hi(const u32x4 w) { return (f32x4){__uint_as_float(w.z << 16), __uint_as_float(w.z & 0xffff0000u), __uint_as_float(w.w << 16), __uint_as_float(w.w & 0xffff0000u)}; }
struct BranchOrder {
    const char* A0; const char* A1; const char* B0; const char* B1; int nM, nN, G, c;
    DEVINL bool next(int i, Unit& u) const { const long L = (long)(i >> 1) * G + c; if (L >= (long)nM * nN) return false; pg8::order_decode(L, nM, nN, u.pm, u.pn); u.e = i & 1; u.r0 = 0; return true; }
    DEVINL const char* a_base(const Unit& u) const { return (u.e ? A1 : A0) + (size_t)u.pm * (256 * 512 * 2); }
    DEVINL const char* b_base(const Unit& u) const { return (u.e ? B1 : B0) + (size_t)u.pn * (256 * 512 * 2); }
    DEVINL bool is_mid(const Unit& u) const { return u.e == 0; }
    DEVINL void a_offsets(const Unit&, const int (&Rl)[2], const int (&Cl)[2], unsigned (&off)[2][2]) const {
#pragma unroll
        for (int h = 0; h < 2; ++h)
#pragma unroll
            for (int i = 0; i < 2; ++i) off[h][i] = (unsigned)((h * 128 + Rl[i]) * 512 + Cl[i]) * 2u;
    }
};
struct EpiBranchChain {
    static constexpr bool PERM = true;
    const bf16_t* GA; const bf16_t* GB; bf16_t* M;
    DEVINL void mid(f32x4 (&acc)[2][2][4][2], const Unit& u, int wr, int wc, int fr, int fq) const {
        const int row0 = u.pm * 256 + wr * 64 + fr, col0 = u.pn * 256 + wc * 64 + 8 * fq;
#pragma unroll
        for (int ai = 0; ai < 2; ++ai)
#pragma unroll
            for (int m = 0; m < 4; ++m) { const size_t ro = (size_t)(row0 + ai * 128 + m * 16) * 1024 + col0;
#pragma unroll
                for (int bj = 0; bj < 2; ++bj) { const u32x4 ga = *(const u32x4*)(GA + ro + bj * 32), gb = *(const u32x4*)(GB + ro + bj * 32);
                    const f32x4 a0 = bf4_lo(ga), a1 = bf4_hi(ga), b0 = bf4_lo(gb), b1 = bf4_hi(gb);
#pragma unroll
                    for (int e = 0; e < 4; ++e) { acc[ai][bj][m][0][e] *= a0[e] * __builtin_amdgcn_rcpf(fmaxf(b0[e], 1e-20f)); acc[ai][bj][m][1][e] *= a1[e] * __builtin_amdgcn_rcpf(fmaxf(b1[e], 1e-20f)); } } }
    }
    DEVINL void operator()(const f32x4 (&acc)[2][2][4][2], const Unit& u, int wr, int wc, int fr, int fq) const {
        const int row0 = u.pm * 256 + wr * 64 + fr, col0 = u.pn * 256 + wc * 64 + 8 * fq;
#pragma unroll
        for (int ai = 0; ai < 2; ++ai)
#pragma unroll
            for (int m = 0; m < 4; ++m) { const size_t ro = (size_t)(row0 + ai * 128 + m * 16) * 1024 + col0;
#pragma unroll
                for (int bj = 0; bj < 2; ++bj) { const u32x4 gb = *(const u32x4*)(GB + ro + bj * 32); const f32x4 v0 = acc[ai][bj][m][0] * bf4_lo(gb), v1 = acc[ai][bj][m][1] * bf4_hi(gb);
                    u32x4 w; w.x = cvt_pk_bf16(v0[0], v0[1]); w.y = cvt_pk_bf16(v0[2], v0[3]); w.z = cvt_pk_bf16(v1[0], v1[1]); w.w = cvt_pk_bf16(v1[2], v1[3]);
                    *(u32x4*)(M + ro + bj * 32) = w; } }
    }
};
template <> struct pg8::EpiWide2<EpiBranchChain> { static constexpr bool value = true; };
template <> struct pg8::EpiChain<EpiBranchChain> { static constexpr bool value = true; };
struct EpiOut {
    static constexpr bool PERM = true;
    const float* x; bf16_t* Y1;
    DEVINL void operator()(const f32x4 (&acc)[2][2][4][2], const Unit& u, int wr, int wc, int fr, int fq) const {
        const int row0 = u.pm * 256 + wr * 64 + fr, col0 = u.pn * 256 + wc * 64 + 8 * fq;
#pragma unroll
        for (int ai = 0; ai < 2; ++ai)
#pragma unroll
            for (int m = 0; m < 4; ++m) { const size_t ro = (size_t)(row0 + ai * 128 + m * 16) * 1024 + col0;
#pragma unroll
                for (int bj = 0; bj < 2; ++bj) { const f32x4 x0 = *(const f32x4*)(x + ro + bj * 32), x1 = *(const f32x4*)(x + ro + bj * 32 + 4);
                    const f32x4 v0 = x0 * DN_ALPHA + acc[ai][bj][m][0], v1 = x1 * DN_ALPHA + acc[ai][bj][m][1]; u32x4 w;
                    w.x = cvt_pk_bf16(v0[0], v0[1]); w.y = cvt_pk_bf16(v0[2], v0[3]); w.z = cvt_pk_bf16(v1[0], v1[1]); w.w = cvt_pk_bf16(v1[2], v1[3]);
                    *(u32x4*)(Y1 + ro + bj * 32) = w; } }
    }
};
template <> struct pg8::EpiWide2<EpiOut> { static constexpr bool value = true; };
#ifndef MOE_WGM
#define MOE_WGM 4
#endif
template <int K, bool GU> struct MoeOrder {
    const PG8_LAS int* tab; int nT, nN, G, c;
    const char* Abase; const char* Bbase; const int* counts; const int* ltok;
    DEVINL bool next(int i, Unit& u) const { const long L = (long)i * G + c; if (L >= (long)nT * nN) return false; int tile, pn; pg8::order_decode<MOE_WGM>(L, nT, nN, tile, pn);
        const int packed = __builtin_amdgcn_readfirstlane(tab[tile]); u.pm = tile; u.pn = pn; u.e = packed & 255; u.r0 = (packed >> 8) * 256; return true; }
    DEVINL const char* a_base(const Unit& u) const { return GU ? Abase : Abase + (size_t)u.pm * (256 * K * 2); }
    DEVINL const char* b_base(const Unit& u) const { return Bbase + (size_t)u.e * ((GU ? 2048 : 1024) * K * 2) + (size_t)u.pn * (256 * K * 2); }
    DEVINL void a_offsets(const Unit& u, const int (&Rl)[2], const int (&Cl)[2], unsigned (&off)[2][2]) const {
        if (GU) { const int cnt = counts[u.e];
#pragma unroll
            for (int h = 0; h < 2; ++h)
#pragma unroll
                for (int i = 0; i < 2; ++i) { const int r = u.r0 + h * 128 + Rl[i]; const int tok = r < cnt ? ltok[(size_t)u.e * NTOK + r] : 0; off[h][i] = (unsigned)(tok * K + Cl[i]) * 2u; }
        } else {
#pragma unroll
            for (int h = 0; h < 2; ++h)
#pragma unroll
                for (int i = 0; i < 2; ++i) off[h][i] = (unsigned)((h * 128 + Rl[i]) * K + Cl[i]) * 2u;
        }
    }
};
constexpr float F8_WSCALE = 32.0f;
struct EpiGU8 {
    static constexpr bool PERM = true;
    const float* bgu; unsigned char* ACT;
    DEVINL void operator()(const f32x4 (&acc)[2][2][4][2], const Unit& u, int wr, int wc, int fr, int fq) const {
        const int row0 = u.pm * 256 + wr * 64 + fr, ic0 = u.pn * 128 + wc * 32 + 8 * fq;
        const f32x4* bp = (const f32x4*)(bgu + (size_t)u.e * 2048 + 2 * ic0);
        const f32x4 b0 = bp[0], b1 = bp[1], b2 = bp[2], b3 = bp[3];
        typedef float f2_t __attribute__((ext_vector_type(2)));
        const f2_t bg2[4] = {(f2_t){b0[0], b0[2]}, (f2_t){b1[0], b1[2]}, (f2_t){b2[0], b2[2]}, (f2_t){b3[0], b3[2]}}, bu2[4] = {(f2_t){b0[1], b0[3]}, (f2_t){b1[1], b1[3]}, (f2_t){b2[1], b2[3]}, (f2_t){b3[1], b3[3]}};
        const f2_t sc2 = {1.0f / F8_WSCALE, 1.0f / F8_WSCALE}, kk2 = {-1.702f * 1.4426950408889634f, -1.702f * 1.4426950408889634f}, one2 = {1.0f, 1.0f};
#pragma unroll
        for (int ai = 0; ai < 2; ++ai)
#pragma unroll
            for (int m = 0; m < 4; ++m) { unsigned char* rowp = ACT + (size_t)(row0 + ai * 128 + m * 16) * DFF + ic0; float o[8];
#pragma unroll
                for (int p = 0; p < 4; ++p) { const f32x4 ga = acc[ai][0][m][p >> 1], ua = acc[ai][1][m][p >> 1];
                    f2_t gate = (f2_t){ga[2 * (p & 1)], ga[2 * (p & 1) + 1]} * sc2 + bg2[p], up = (f2_t){ua[2 * (p & 1)], ua[2 * (p & 1) + 1]} * sc2 + bu2[p];
                    gate.x = fminf(gate.x, 7.0f); gate.y = fminf(gate.y, 7.0f); up.x = fminf(fmaxf(up.x, -7.0f), 7.0f); up.y = fminf(fmaxf(up.y, -7.0f), 7.0f);
                    const f2_t t = gate * kk2; f2_t e; e.x = __builtin_amdgcn_exp2f(t.x); e.y = __builtin_amdgcn_exp2f(t.y);
                    const f2_t d = e + one2; f2_t r; r.x = __builtin_amdgcn_rcpf(d.x); r.y = __builtin_amdgcn_rcpf(d.y);
                    const f2_t glu = gate * r, ov = up * glu + glu; o[2 * p] = ov.x; o[2 * p + 1] = ov.y; }
                pg8::u32x2 w; w.x = pk4_fp8(o[0], o[1], o[2], o[3]); w.y = pk4_fp8(o[4], o[5], o[6], o[7]);
                *(pg8::u32x2*)rowp = w; }
    }
};
constexpr float Y2_SCALE = 8.0f;
struct EpiDown8 {
    static constexpr bool PERM = true;
    const float* bd; unsigned char* Y2;
    DEVINL void operator()(const f32x4 (&acc)[2][2][4][2], const Unit& u, int wr, int wc, int fr, int fq) const {
        const int rl0 = wr * 64 + fr, col0 = u.pn * 256 + wc * 64 + 16 * fq;
        f32x4 bv[2][2];
#pragma unroll
        for (int bj = 0; bj < 2; ++bj)
#pragma unroll
            for (int n = 0; n < 2; ++n) bv[bj][n] = *(const f32x4*)(bd + (size_t)u.e * DM + col0 + 8 * bj + 4 * n) * Y2_SCALE;
#pragma unroll
        for (int ai = 0; ai < 2; ++ai)
#pragma unroll
            for (int m = 0; m < 4; ++m) { const int rl = rl0 + ai * 128 + m * 16; u32x4 w;
                { const f32x4 v = acc[ai][0][m][0] * (Y2_SCALE / F8_WSCALE) + bv[0][0]; w.x = pk4_fp8(v[0], v[1], v[2], v[3]); }
                { const f32x4 v = acc[ai][0][m][1] * (Y2_SCALE / F8_WSCALE) + bv[0][1]; w.y = pk4_fp8(v[0], v[1], v[2], v[3]); }
                { const f32x4 v = acc[ai][1][m][0] * (Y2_SCALE / F8_WSCALE) + bv[1][0]; w.z = pk4_fp8(v[0], v[1], v[2], v[3]); }
                { const f32x4 v = acc[ai][1][m][1] * (Y2_SCALE / F8_WSCALE) + bv[1][1]; w.w = pk4_fp8(v[0], v[1], v[2], v[3]); }
                *(u32x4*)(Y2 + (size_t)(u.pm * 256 + rl) * DM + col0) = w; }
    }
};
template <> struct pg8::EpiWide<EpiDown8> { static constexpr bool value = true; };
#define XB_TMO      128
#define XB_XCNT(j)  (256  + 64 * (j))
#define XB_XSUB(j)  (1280 + 64 * (j))
#define XB_XGEN(j)  (2304 + 64 * (j))
#define XB_TOP      3328
#define XB_TOPGEN   3392
#define XCD_BAR_WORDS 3456
#define XB_SPIN_CAP (1u << 18)
#define LAS __attribute__((address_space(3)))
__device__ __forceinline__ unsigned xb_ld(unsigned* p)              { return __hip_atomic_load(p, __ATOMIC_RELAXED, __HIP_MEMORY_SCOPE_AGENT); }
__device__ __forceinline__ unsigned xb_add(unsigned* p, unsigned v) { return __hip_atomic_fetch_add(p, v, __ATOMIC_RELAXED, __HIP_MEMORY_SCOPE_AGENT); }
__device__ __forceinline__ unsigned xb_xcc_id() { return (unsigned)__builtin_amdgcn_s_getreg((3 << 11) | 20) & 0xFu; }
#define XB_SPIN(cond, bar) do { unsigned _sp = 0; while (cond) { __builtin_amdgcn_s_sleep(1); \
    if ((++_sp & 255u) == 0u) { if (xb_ld(&(bar)[XB_TMO])) break; if (_sp > XB_SPIN_CAP) { atomicAdd(&(bar)[XB_TMO], 1u); break; } } } } while (0)
struct XcdBarrier { unsigned* bar; unsigned x; volatile LAS unsigned* st; };
__device__ __forceinline__ XcdBarrier xcd_barrier_post(unsigned* bar, volatile LAS unsigned* st) {
    XcdBarrier b; b.bar = bar; b.x = xb_xcc_id(); b.st = st;
    if (threadIdx.x == 0) (void)xb_add(&bar[XB_XCNT(b.x)], 1u);
    return b;
}
__device__ __forceinline__ void xcd_barrier_complete(unsigned* bar, unsigned x, unsigned& nloc, unsigned& nx) {
    const unsigned G = gridDim.x * gridDim.y * gridDim.z;
    unsigned sum, cnt, mine, sp = 0u;
    for (;;) {
        sum = 0u; cnt = 0u; mine = 0u;
#pragma unroll
        for (unsigned j = 0; j < 16; ++j) { const unsigned c = xb_ld(&bar[XB_XCNT(j)]); sum += c; cnt += (c > 0u) ? 1u : 0u; mine = (j == x) ? c : mine; }
        if (sum == G) break;
        __builtin_amdgcn_s_sleep(1);
        if ((++sp & 255u) == 0u) { if (xb_ld(&bar[XB_TMO])) break; if (sp > XB_SPIN_CAP) { atomicAdd(&bar[XB_TMO], 1u); break; } }
    }
    nloc = mine > 0u ? mine : 1u; nx = cnt > 0u ? cnt : 1u;
}
__device__ __forceinline__ void xcd_barrier(const XcdBarrier& b) {
    asm volatile("s_waitcnt vmcnt(0)" ::: "memory");
    __syncthreads();
    if (threadIdx.x == 0) {
        unsigned* bar = b.bar;
        __builtin_amdgcn_s_waitcnt(0);
        unsigned nloc = b.st[0], nx = b.st[1];
        if (nloc == 0u) { xcd_barrier_complete(bar, b.x, nloc, nx); b.st[0] = nloc; b.st[1] = nx; }
        const unsigned old = xb_add(&bar[XB_XSUB(b.x)], 1u);
        const unsigned gen = old / nloc;
        if (old + 1u == (gen + 1u) * nloc) {
            __builtin_amdgcn_fence(__ATOMIC_RELEASE, "agent");
            asm volatile("s_waitcnt vmcnt(0)" ::: "memory");
            const unsigned og = xb_add(&bar[XB_TOP], 1u);
            const unsigned tg = og / nx;
            if (og + 1u == (tg + 1u) * nx) xb_add(&bar[XB_TOPGEN], 1u);
            else XB_SPIN(xb_ld(&bar[XB_TOPGEN]) == tg, bar);
            __builtin_amdgcn_fence(__ATOMIC_ACQUIRE, "agent");
            xb_add(&bar[XB_XGEN(b.x)], 1u);
            asm volatile("s_waitcnt vmcnt(0)" ::: "memory");
        } else {
            XB_SPIN(xb_ld(&bar[XB_XGEN(b.x)]) == gen, bar);
            __builtin_amdgcn_fence(__ATOMIC_ACQUIRE, "agent");
            asm volatile("s_waitcnt vmcnt(0)" ::: "memory");
        }
    }
    __syncthreads();
}

constexpr int RING_BYTES = 131072, LDS_BYTES = 150528;
constexpr int LC_MISC = 0  , LC_PRE = 256  , LC_TAB = 512  ;
constexpr size_t CTL_OFF = OFF_SMALL + 4096, CTL_BYTES = 65536, CTL_BAR = 1024;
enum { PH_PRO = 0, PH_INPROJ = 1, PH_HGA = 2, PH_ATT = 3, PH_BRANCH = 4, PH_OUT = 5, PH_LN1 = 6, PH_GU = 7, PH_DOWN = 8, PH_LN2 = 9, PH_END = 10 };
struct Args { const float* in[19]; float* out; unsigned char* ws; int ph_lo, ph_hi, li, pad; };


constexpr int RING_BYTES_C = 131072, LDSCTL_OFF = 131072;
typedef unsigned v4u_t __attribute__((ext_vector_type(4)));
DEVINL unsigned pk2bf(float lo, float hi) { return (unsigned)f2bf(lo) | ((unsigned)f2bf(hi) << 16); }
template <bool GUPERM> DEVINL void transpose_item(const float* W, int K, int N, bf16_t* WT, int item, int lane, int ld = 0) {
    if (ld == 0) ld = N;
    const int nblk = N / 64, kb = item / nblk, nb = item % nblk, k0 = 64 * kb + 16 * (lane >> 4), n0 = 64 * nb + 4 * (lane & 15);
    f32x4 v[16];
#pragma unroll
    for (int i = 0; i < 16; ++i) v[i] = *(const f32x4*)(W + (size_t)(k0 + i) * ld + n0);
#pragma unroll
    for (int n = 0; n < 4; ++n) { int nn = n0 + n; if (GUPERM) { const int ii = nn >> 1, g = nn & 1; nn = 256 * (ii >> 7) + 128 * g + (ii & 127); }
        v4u_t o0, o1; o0.x = pk2bf(v[0][n], v[1][n]); o0.y = pk2bf(v[2][n], v[3][n]); o0.z = pk2bf(v[4][n], v[5][n]); o0.w = pk2bf(v[6][n], v[7][n]);
        o1.x = pk2bf(v[8][n], v[9][n]); o1.y = pk2bf(v[10][n], v[11][n]); o1.z = pk2bf(v[12][n], v[13][n]); o1.w = pk2bf(v[14][n], v[15][n]);
        v4u_t* dst = (v4u_t*)(WT + (size_t)nn * K + k0); dst[0] = o0; dst[1] = o1; }
}
template <bool GUPERM> DEVINL void transpose_item_f8(const float* W, int K, int N, unsigned char* WT, int item, int lane, int ld = 0) {
    if (ld == 0) ld = N;
    const int nblk = N / 64, kb = item / nblk, nb = item % nblk, k0 = 64 * kb + 16 * (lane >> 4), n0 = 64 * nb + 4 * (lane & 15);
    f32x4 v[16];
#pragma unroll
    for (int i = 0; i < 16; ++i) v[i] = *(const f32x4*)(W + (size_t)(k0 + i) * ld + n0);
    unsigned t[4][4];
#pragma unroll
    for (int kq = 0; kq < 4; ++kq) { unsigned r[4];
#pragma unroll
        for (int m = 0; m < 4; ++m) { const f32x4 q = v[4 * kq + m] * F8_WSCALE; r[m] = pk4_fp8(q[0], q[1], q[2], q[3]); }
        const unsigned x0 = __builtin_amdgcn_perm(r[1], r[0], 0x05010400u), x1 = __builtin_amdgcn_perm(r[1], r[0], 0x07030602u), y0 = __builtin_amdgcn_perm(r[3], r[2], 0x05010400u), y1 = __builtin_amdgcn_perm(r[3], r[2], 0x07030602u);
        t[kq][0] = __builtin_amdgcn_perm(y0, x0, 0x05040100u); t[kq][1] = __builtin_amdgcn_perm(y0, x0, 0x07060302u); t[kq][2] = __builtin_amdgcn_perm(y1, x1, 0x05040100u); t[kq][3] = __builtin_amdgcn_perm(y1, x1, 0x07060302u); }
#pragma unroll
    for (int n = 0; n < 4; ++n) { int nn = n0 + n; if (GUPERM) { const int ii = nn >> 1, g = nn & 1; nn = 256 * (ii >> 7) + 128 * g + (ii & 127); }
        *(u32x4*)(WT + (size_t)nn * K + k0) = (u32x4){t[0][n], t[1][n], t[2][n], t[3][n]}; }
}
DEVINL void phase_prologue(const Args& a, unsigned char* ws, LAS unsigned char* lds, int G) {
    const int tid = opaque_tid(), lane = tid & 63, wave = tid >> 6;
    float* smallf = (float*)(ws + OFF_SMALL);
    if (blockIdx.x == 0) {
        const float* lbl = a.in[2]; const float* dl = a.in[4];
        smallf[tid] = 1.0f / (1.0f + expf(lbl[512 + tid] - lbl[tid]));
        if (tid < 64) { float p = dl[tid] * dl[64 + tid], q = dl[128 + tid] * dl[192 + tid]; p = wave_sum(p); q = wave_sum(q); if (tid == 0) smallf[512] = expf(p) - expf(q) + LAMBDA_INIT; }
    }
    { const float4* x4 = (const float4*)a.in[0]; uint4* xb = (uint4*)(ws + OFF_XB); const size_t n8 = (size_t)NTOK * DM / 8;
      for (size_t i = (size_t)blockIdx.x * 512 + tid; i < n8; i += (size_t)G * 512) { const float4 p = x4[2 * i], q = x4[2 * i + 1];
          uint4 o; o.x = pk2bf(p.x, p.y); o.y = pk2bf(p.z, p.w); o.z = pk2bf(q.x, q.y); o.w = pk2bf(q.z, q.w); xb[i] = o;
          uint2 o8; o8.x = pk4_fp8(p.x, p.y, p.z, p.w); o8.y = pk4_fp8(q.x, q.y, q.z, q.w); ((uint2*)(ws + OFF_XB8))[i] = o8; } }
    const int gw = blockIdx.x * 8 + wave, NGW = G * 8;
    constexpr int I_IN = (DM / 64) * (DIN / 32), I_A = (512 / 64) * (DM / 64), I_O = (DM / 64) * (DM / 64);
    constexpr int NIT = I_IN + 2 * I_A + I_O;
    for (int it = gw; it < NIT; it += NGW) {
        int r = it;
        if (r < I_IN) {
            const int kb = r / (DIN / 32), nb = r % (DIN / 32), seg = nb >> 4;
            const bool g8 = (seg == 3) || (seg >= 7); const int dseg = g8 ? (seg == 3 ? 0 : seg - 6) : (seg < 3 ? seg : seg - 1);
            if (g8) { if (!(nb & 1)) transpose_item_f8<false>(a.in[1] + seg * 512, DM, 512, (unsigned char*)(ws + OFF_WIN8) + (size_t)dseg * 512 * DM, kb * 8 + ((nb & 15) >> 1), lane, DIN); }
            else { if (!(nb & 1)) transpose_item<false>(a.in[1] + seg * 512, DM, 512, (bf16_t*)(ws + OFF_WIN) + (size_t)dseg * 512 * DM, kb * 8 + ((nb & 15) >> 1), lane, DIN); }
            continue; } r -= I_IN;
        if (r < I_A) { transpose_item<false>(a.in[6], 512, DM, (bf16_t*)(ws + OFF_WA), r, lane); continue; } r -= I_A;
        if (r < I_A) { transpose_item<false>(a.in[7], 512, DM, (bf16_t*)(ws + OFF_WB), r, lane); continue; } r -= I_A;
        transpose_item<false>(a.in[8], DM, DM, (bf16_t*)(ws + OFF_WOUT), r, lane);
    }
}
typedef float f32x16 __attribute__((ext_vector_type(16)));
typedef short s16x4_t __attribute__((ext_vector_type(4)));
constexpr size_t CTLX_OFF = OFF_SMALL + 4096;
__device__ const unsigned char ATT_ORDER[64] = {63, 47, 62, 46, 61, 45, 60, 44, 59, 43, 58, 42, 57, 41, 56, 40, 55, 39, 54, 38, 53, 37, 52, 36, 31, 30, 29, 28, 27, 26, 25, 24, 23, 22, 21, 20, 51, 35, 19, 50, 34, 18, 49, 33, 17, 15, 14, 13, 12, 11, 10, 9, 8, 7, 6, 5, 4, 3, 2, 1, 48, 32, 16, 0};
DEVINL int crow(int r, int hi) { return (r & 3) + 8 * (r >> 2) + 4 * hi; }
DEVINL s16x4_t lds_tr16(LAS const unsigned char* p) { return __builtin_bit_cast(s16x4_t, __builtin_amdgcn_ds_read_tr16_b64_v4i16((LAS s16x4_t*)p)); }
constexpr int AT_PK = 144, AT_PV = 320, AT_KBUF = 64 * AT_PK, AT_VBUF = 64 * AT_PV, AT_BUF = AT_KBUF + AT_VBUF, AT_SCR = 2 * AT_BUF, AT_O0 = AT_SCR + 1024;
constexpr float AT_THR = 8.0f, AT_SKIP = 64.0f;
DEVINL void attn_unit(int b, int h, int qb, int j, const bf16_t* DQ, const bf16_t* DK, const bf16_t* DV, bf16_t* OB, unsigned* O0G, unsigned* ctlx, const float* NG, float lam, LAS unsigned char* lds) {
    int tid_ = threadIdx.x; asm volatile("" : "+v"(tid_));
    const int tid = tid_, lane = tid & 63, wid = __builtin_amdgcn_readfirstlane(tid >> 6), r32 = lane & 31, hi = lane >> 5;
    const int q0 = qb * 256, qw0 = q0 + wid * 32, qpos = qw0 + r32;
    const size_t rowb = (size_t)b * SEQ;
    const float c = exp2f(-2.0f * (float)(h + 1)) * 1.4426950408889634f;
    bf16x8 qf[4];
#pragma unroll
    for (int d0 = 0; d0 < 4; ++d0) qf[d0] = *(const bf16x8*)(DQ + (rowb + qpos) * 512 + h * 128 + j * 64 + d0 * 16 + hi * 8);
    float qkb;
    { float q2 = 0.f;
#pragma unroll
      for (int d0 = 0; d0 < 4; ++d0)
#pragma unroll
          for (int e = 0; e < 8; ++e) { const float v = bf2f((bf16_t)qf[d0][e]); q2 += v * v; }
      q2 += __shfl_xor(q2, 32);
      qkb = sqrtf(q2) * sqrtf(__uint_as_float(ctlx[128 + b * 8 + h * 2 + j])) * 1.001f; }
    f32x16 cr;
#pragma unroll
    for (int r = 0; r < 16; ++r) cr[r] = c * (float)crow(r, hi);
    f32x16 o[4];
#pragma unroll
    for (int d = 0; d < 4; ++d)
#pragma unroll
        for (int r = 0; r < 16; ++r) o[d][r] = 0.f;
    float mref = -1e30f, lsum = 0.f;
    const int nt = 4 * (qb + 1), sw = 7 - wid;
    const int kkv = tid >> 3, kch = tid & 7, vkv = tid >> 4, vch = tid & 15;
    const bf16_t* kg = DK + (rowb + kkv) * 512 + h * 128 + j * 64 + kch * 8;
    const bf16_t* vg = DV + (rowb + vkv) * 512 + h * 128 + vch * 8;
    const int kdst = kkv * AT_PK + kch * 16, vdst = AT_KBUF + vkv * AT_PV + vch * 16;
    const int kread = r32 * AT_PK + hi * 16;
    const int vread = AT_KBUF + (4 * hi + ((lane & 15) >> 2)) * AT_PV + ((lane >> 4) & 1) * 32 + (lane & 3) * 8;
    LAS float* scr = (LAS float*)(lds + AT_SCR) + wid * 32;
    LAS unsigned* votes = (LAS unsigned*)(lds + LDSCTL_OFF + 320);
    u32x4 kr = *(const u32x4*)(kg + (size_t)(nt - 1) * 64 * 512), vr0, vr1;
    __syncthreads();
    *(LAS u32x4*)(lds + kdst) = kr; *(LAS u32x4*)(lds + AT_BUF + vdst) = kr;
    kr = *(const u32x4*)(kg + (size_t)(nt - 2) * 64 * 512); vr0 = *(const u32x4*)(vg + (size_t)(nt - 1) * 64 * 512); vr1 = *(const u32x4*)(vg + ((size_t)(nt - 1) * 64 + 32) * 512);
    __syncthreads();
    f32x16 pA = cr, pB = cr; u32x4 paw[2] = {(u32x4){0u, 0u, 0u, 0u}, (u32x4){0u, 0u, 0u, 0u}};
#define AT_SB() __builtin_amdgcn_sched_barrier(0)
#define AT_PIN(x) asm volatile("" : "+v"(x))
#define AT_MF(a, b, c) __builtin_amdgcn_mfma_f32_32x32x16_bf16(a, b, c, 0, 0, 0)
#define AT_VLD(K_, S2, D) do { l##K_ = lds_tr16(lds + ubv_ + vread + (16 * (S2)) * AT_PV + 64 * (D)); h##K_ = lds_tr16(lds + ubv_ + vread + (16 * (S2) + 8) * AT_PV + 64 * (D)); } while (0)
#define AT_VF(K_) ((bf16x8){l##K_[0], l##K_[1], l##K_[2], l##K_[3], h##K_[0], h##K_[1], h##K_[2], h##K_[3]})
#define AT_KLD(K_, D0) k##K_ = *(LAS const bf16x8*)(lds + ubk_ + kread + (D0) * 32)
#define AT_GB(PC, S2, D, K_, NEXT, R) do { o[D] = AT_MF(__builtin_bit_cast(bf16x8, paw[S2]), AT_VF(K_), o[D]); NEXT; \
        PC[R] = __builtin_amdgcn_exp2f(PC[R] + e_); PC[(R) + 1] = __builtin_amdgcn_exp2f(PC[(R) + 1] + e_); AT_PIN(PC); AT_SB(); } while (0)
#define AT_GA(PC, PN, D0, K_, CIN, NEXT, R, W0, W1, PW) do { PN = AT_MF(k##K_, qf[D0], CIN); NEXT; \
        ps_ += PC[R]; ps_ += PC[(R) + 1]; ps_ += PC[(R) + 2]; ps_ += PC[(R) + 3]; W0 = cvt_pk_bf16(PC[R], PC[(R) + 1]); W1 = cvt_pk_bf16(PC[(R) + 2], PC[(R) + 3]); AT_PIN(PW); AT_PIN(ps_); AT_SB(); } while (0)
#define AT_STEP(PC, PN, S) do { \
        const int ubk_ = ((((S) + 1) >> 1) & 1) * AT_BUF + (1 - (((S) + 1) & 1)) * 32 * AT_PK, ubv_ = ((((S) - 1) >> 1) & 1) * AT_BUF + (1 - (((S) - 1) & 1)) * 32 * AT_PV; \
        s16x4_t l0, h0, l1, h1, l2, h2; bf16x8 k0, k1, k2; \
        AT_SB(); AT_VLD(0, 0, 0); AT_VLD(1, 0, 1); AT_SB(); \
        if ((S) <= sw) { int lim_ = (S) < sw ? -1 : r32; asm volatile("" : "+v"(lim_)); _Pragma("unroll") for (int r = 0; r < 16; ++r) if (crow(r, hi) > lim_) PC[r] = -INFINITY; } \
        const float tb_ = c * (float)(224 - 32 * (S)); \
        float m0_ = fmaxf(fmaxf(PC[0], PC[1]), PC[2]), m1_ = fmaxf(fmaxf(PC[3], PC[4]), PC[5]); \
        m0_ = fmaxf(fmaxf(m0_, PC[6]), PC[7]); m1_ = fmaxf(fmaxf(m1_, PC[8]), PC[9]); m0_ = fmaxf(fmaxf(m0_, PC[10]), PC[11]); m1_ = fmaxf(fmaxf(m1_, PC[12]), PC[13]); m0_ = fmaxf(fmaxf(m0_, PC[14]), PC[15]); \
        float mt_ = fmaxf(m0_, m1_) + tb_; { const auto rr_ = __builtin_amdgcn_permlane32_swap(__float_as_uint(mt_), __float_as_uint(mt_), false, false); mt_ = fmaxf(__uint_as_float(rr_[0]), __uint_as_float(rr_[1])); } \
        const bool resc_ = __any(mt_ > mref + AT_THR); \
        if (resc_) { const float mnew_ = fmaxf(mref, mt_); const float alpha_ = __builtin_amdgcn_exp2f(mref - mnew_); lsum *= alpha_; mref = mnew_; if (hi == 0) scr[r32] = alpha_; } \
        const float e_ = tb_ - mref; float ps_ = 0.f; AT_SB(); \
        AT_GB(PC, 0, 0, 0, AT_VLD(2, 0, 2), 0); AT_GB(PC, 0, 1, 1, AT_VLD(0, 0, 3), 2); AT_GB(PC, 0, 2, 2, AT_VLD(1, 1, 0), 4); AT_GB(PC, 0, 3, 0, AT_VLD(2, 1, 1), 6); \
        AT_GB(PC, 1, 0, 1, AT_VLD(0, 1, 2), 8); AT_GB(PC, 1, 1, 2, AT_VLD(1, 1, 3), 10); AT_GB(PC, 1, 2, 0, AT_KLD(0, 0), 12); AT_GB(PC, 1, 3, 1, AT_KLD(1, 1), 14); \
        AT_GA(PC, PN, 0, 0, cr, AT_KLD(2, 2), 0, paw[0].x, paw[0].y, paw[0]); AT_GA(PC, PN, 1, 1, PN, AT_KLD(0, 3), 4, paw[0].z, paw[0].w, paw[0]); \
        AT_GA(PC, PN, 2, 2, PN, (void)0, 8, paw[1].x, paw[1].y, paw[1]); AT_GA(PC, PN, 3, 0, PN, (void)0, 12, paw[1].z, paw[1].w, paw[1]); \
        lsum += ps_; \
        if (resc_) { _Pragma("unroll") for (int r = 0; r < 16; ++r) { const float a_ = scr[crow(r, hi)]; _Pragma("unroll") for (int d = 0; d < 4; ++d) o[d][r] *= a_; } } } while (0)
    __builtin_amdgcn_sched_barrier(0);
    { bf16x8 kf_[4];
#pragma unroll
      for (int d0 = 0; d0 < 4; ++d0) kf_[d0] = *(LAS const bf16x8*)(lds + 32 * AT_PK + kread + d0 * 32);
      pA = __builtin_amdgcn_mfma_f32_32x32x16_bf16(kf_[0], qf[0], cr, 0, 0, 0);
#pragma unroll
      for (int d0 = 1; d0 < 4; ++d0) pA = __builtin_amdgcn_mfma_f32_32x32x16_bf16(kf_[d0], qf[d0], pA, 0, 0, 0); }
    __builtin_amdgcn_sched_barrier(0);
    const int nsteps = 2 * nt; int s_last = nsteps - 1;
    for (int i = 0; i < nt; ++i) {
        if (2 * i + 1 >= sw) AT_STEP(pA, pB, 2 * i);
        if (i + 1 < nt) *(LAS u32x4*)(lds + ((i + 1) & 1) * AT_BUF + kdst) = kr;
        *(LAS u32x4*)(lds + (i & 1) * AT_BUF + vdst) = vr0; *(LAS u32x4*)(lds + (i & 1) * AT_BUF + vdst + 32 * AT_PV) = vr1;
        if (i + 2 < nt) kr = *(const u32x4*)(kg + (size_t)(nt - 3 - i) * 64 * 512);
        if (i + 1 < nt) { vr0 = *(const u32x4*)(vg + (size_t)(nt - 2 - i) * 64 * 512); vr1 = *(const u32x4*)(vg + ((size_t)(nt - 2 - i) * 64 + 32) * 512); }
        { const bool done_ = __all(qkb + c * (float)(255 - 32 * (2 * i + 1)) < mref - AT_SKIP);
          if (lane == 0) votes[(i & 1) * 8 + wid] = done_ ? 1u : 0u; }
        __syncthreads();
        { const u32x4 v0_ = *(LAS const u32x4*)(votes + (i & 1) * 8), v1_ = *(LAS const u32x4*)(votes + (i & 1) * 8 + 4);
          if ((v0_.x & v0_.y & v0_.z & v0_.w & v1_.x & v1_.y & v1_.z & v1_.w) != 0u) { s_last = 2 * i; break; } }
        if (2 * i + 2 >= sw) AT_STEP(pB, pA, 2 * i + 1);
    }
    { const int ubv_ = ((s_last >> 1) & 1) * AT_BUF + (1 - (s_last & 1)) * 32 * AT_PV;
#pragma unroll
      for (int s2 = 0; s2 < 2; ++s2) { s16x4_t lo_[4], hh_[4];
#pragma unroll
          for (int d = 0; d < 4; ++d) { lo_[d] = lds_tr16(lds + ubv_ + vread + (16 * s2) * AT_PV + 64 * d); hh_[d] = lds_tr16(lds + ubv_ + vread + (16 * s2 + 8) * AT_PV + 64 * d); }
#pragma unroll
          for (int d = 0; d < 4; ++d) { const bf16x8 vf_ = (bf16x8){lo_[d][0], lo_[d][1], lo_[d][2], lo_[d][3], hh_[d][0], hh_[d][1], hh_[d][2], hh_[d][3]};
              o[d] = __builtin_amdgcn_mfma_f32_32x32x16_bf16(__builtin_bit_cast(bf16x8, paw[s2]), vf_, o[d], 0, 0, 0); } } }
#undef AT_SB
#undef AT_PIN
#undef AT_MF
#undef AT_VLD
#undef AT_VF
#undef AT_KLD
#undef AT_GB
#undef AT_GA
#undef AT_STEP
    lsum += __shfl_xor(lsum, 32);
    asm volatile("" ::: "memory");
    if (hi == 0) scr[r32] = 1.0f / lsum;
    const int item3 = (b * 4 + h) * 16 + qb;
    unsigned* o0s = O0G + ((size_t)item3 * 8 + wid) * 2048 + lane;
    unsigned* flag = ctlx + 4096 + item3;
    if (j == 0) {
#pragma unroll
        for (int r = 0; r < 16; ++r) { const float il = scr[crow(r, hi)];
#pragma unroll
            for (int d = 0; d < 4; d += 2) __hip_atomic_store(o0s + ((d >> 1) * 16 + r) * 64, cvt_pk_bf16(o[d][r] * il, o[d + 1][r] * il), __ATOMIC_RELAXED, __HIP_MEMORY_SCOPE_AGENT); }
        asm volatile("s_waitcnt vmcnt(0)" ::: "memory");
        __syncthreads();
        if (tid == 0) __hip_atomic_store(flag, 1u, __ATOMIC_RELAXED, __HIP_MEMORY_SCOPE_AGENT);
    } else {
        if (tid == 0) { unsigned sp = 0; while (__hip_atomic_load(flag, __ATOMIC_RELAXED, __HIP_MEMORY_SCOPE_AGENT) == 0u) { __builtin_amdgcn_s_sleep(8); if (++sp > (1u << 22)) break; } }
        __syncthreads();
        float ngv[4];
#pragma unroll
        for (int d = 0; d < 4; ++d) ngv[d] = NG[h * 128 + 32 * d + r32] * (1.0f - LAMBDA_INIT);
#pragma unroll
        for (int r = 0; r < 16; ++r) { const float il = scr[crow(r, hi)]; float x[4]; float q2 = 0.f;
#pragma unroll
            for (int d = 0; d < 4; d += 2) { const unsigned w = __hip_atomic_load(o0s + ((d >> 1) * 16 + r) * 64, __ATOMIC_RELAXED, __HIP_MEMORY_SCOPE_AGENT);
                x[d] = __uint_as_float(w << 16) - lam * (o[d][r] * il); x[d + 1] = __uint_as_float(w & 0xffff0000u) - lam * (o[d + 1][r] * il); q2 += x[d] * x[d] + x[d + 1] * x[d + 1]; }
            q2 += __shfl_xor(q2, 1); q2 += __shfl_xor(q2, 2); q2 += __shfl_xor(q2, 4); q2 += __shfl_xor(q2, 8); q2 += __shfl_xor(q2, 16);
            const float rn = rsqrtf(q2 * (1.0f / 128.0f) + 1e-6f); const size_t row = rowb + qw0 + crow(r, hi);
#pragma unroll
            for (int d = 0; d < 4; ++d) OB[row * 512 + h * 128 + 32 * d + r32] = f2bf(x[d] * rn * ngv[d]); }
    }
}
DEVINL void moe_cvt_item(const Args& a, unsigned char* ws, LAS unsigned char* lds, int item) {
    const int tid = opaque_tid(), lane = tid & 63, wave = tid >> 6;
    constexpr int I_GU = (DM / 64) * (2048 / 64), I_D = (DFF / 64) * (DM / 64);
    for (int t = 0; t < 6; ++t) { int r = item * 48 + t * 8 + wave;
        if (r < NEXP * I_GU) { const int e = r / I_GU; transpose_item_f8<true>(a.in[13] + (size_t)e * DM * 2048, DM, 2048, (unsigned char*)(ws + OFF_WGU) + (size_t)e * 2048 * DM, r % I_GU, lane); }
        else { r -= NEXP * I_GU; const int e = r / I_D; transpose_item_f8<false>(a.in[15] + (size_t)e * DFF * DM, DFF, DM, (unsigned char*)(ws + OFF_WD) + (size_t)e * DM * DFF, r % I_D, lane); } }
}
DEVINL void attn_phase(const Args& a, unsigned char* ws, LAS unsigned char* lds, int G) {
    const bf16_t* DQ = (const bf16_t*)(ws + OFF_DQ); const bf16_t* DK = (const bf16_t*)(ws + OFF_DK); const bf16_t* DV = (const bf16_t*)(ws + OFF_DV); bf16_t* OB = (bf16_t*)(ws + OFF_OB);
    const float lam = ((const float*)(ws + OFF_SMALL))[512]; const float* NG = a.in[5];
    unsigned* ctlx = (unsigned*)(ws + CTLX_OFF);
    LAS unsigned* qslot = (LAS unsigned*)(lds + LDSCTL_OFF + 256);
    for (;;) {
        __syncthreads();
        if (threadIdx.x == 0) *qslot = __hip_atomic_fetch_add(ctlx + 64, 1u, __ATOMIC_RELAXED, __HIP_MEMORY_SCOPE_AGENT);
        __syncthreads();
        const unsigned idx = *qslot;
        if (idx >= 1536u) break;
        if (idx % 3u == 2u) { moe_cvt_item(a, ws, lds, (int)(idx / 3u)); continue; }
        const unsigned it = idx - (idx + 1u) / 3u;
        const int j = (int)(it >> 9), ord = ATT_ORDER[(it >> 3) & 63], b = (int)(it & 7), h = ord >> 4, qb = ord & 15;
        attn_unit(b, h, qb, j, DQ, DK, DV, OB, (unsigned*)(ws + OFF_OJ), ctlx, NG, lam, lds);
    }
}

constexpr int HG_PQ = 272, HG_PT = 144, HG_PV = 320, HG_PS = 272;
constexpr int HG_QD = 0, HG_KI = HG_QD + 64 * HG_PQ, HG_KDT = HG_KI + 64 * HG_PQ, HG_VT = HG_KDT + 128 * HG_PT, HG_ST = HG_VT + 64 * HG_PV, HG_DVEC = HG_ST + 128 * HG_PS, HG_SEG = HG_DVEC + 512, HG_END = HG_SEG + 2048;
static_assert(HG_END + 1024 <= RING_BYTES_C, "hgrn LDS");
constexpr size_t OFF_DTOT = OFF_SMALL + 128 * 1024;
template <bool WITH_OUT>
DEVINL void hgrn_unit(int unit, const bf16_t* QA, const _Float16* LF, const bf16_t* HV, const bf16_t* HGp, const float* NG, bf16_t* OAp, float* U, float* DTOT, LAS unsigned char* lds) {
    int tid_ = threadIdx.x; asm volatile("" : "+v"(tid_));
    const int tid = tid_, lane = tid & 63, wid = __builtin_amdgcn_readfirstlane(tid >> 6), r32 = lane & 31, hi = lane >> 5, tb = wid >> 2, vb = wid & 3;
    const int kel = tid & 127, seg = tid >> 7;
    const int bh = unit >> 3, sc = unit & 7, b = bh >> 2, h = bh & 3;
    const size_t tok0 = (size_t)b * SEQ + (size_t)sc * 512;
    LAS float* dvec = (LAS float*)(lds + HG_DVEC); LAS float* segt = (LAS float*)(lds + HG_SEG); LAS float* ssq = (LAS float*)(lds + HG_END);
    f32x16 st[2];
#pragma unroll
    for (int i = 0; i < 2; ++i)
#pragma unroll
        for (int r = 0; r < 16; ++r) st[i][r] = 0.f;
    if (WITH_OUT && sc > 0) {
        f32x4 un[2][4], dn[2][4];
#define HG_LDUD(UJ) do { _Pragma("unroll") for (int i = 0; i < 2; ++i) _Pragma("unroll") for (int g = 0; g < 4; ++g) { \
            un[i][g] = *(const f32x4*)(U + (((((size_t)(UJ) * 8 + wid) * 2 + i) * 4 + g) * 64 + lane) * 4); dn[i][g] = *(const f32x4*)(DTOT + (UJ) * 128 + 32 * (2 * tb + i) + 8 * g + 4 * hi); } } while (0)
        HG_LDUD(bh * 8);
        for (int jj = 0; jj < sc; ++jj) {
            f32x4 uc[2][4], dc[2][4];
#pragma unroll
            for (int i = 0; i < 2; ++i)
#pragma unroll
                for (int g = 0; g < 4; ++g) { uc[i][g] = un[i][g]; dc[i][g] = dn[i][g]; }
            { const int ujn = bh * 8 + min(jj + 1, sc - 1); HG_LDUD(ujn); }
#pragma unroll
            for (int i = 0; i < 2; ++i)
#pragma unroll
                for (int g = 0; g < 4; ++g)
#pragma unroll
                    for (int e = 0; e < 4; ++e) st[i][4 * g + e] = st[i][4 * g + e] * dc[i][g][e] + uc[i][g][e];
        }
#undef HG_LDUD
    }
    float ltot = 0.f;
    const int vkv = tid >> 4, vch = tid & 15;
    _Float16 lfh[16]; bf16_t qav[16]; u32x4 vg0, vg1; pg8::u32x2 gate[4]; f32x4 ngv[4];
#define HG_LOADS(CH) do { const size_t t0n_ = tok0 + (CH) * 64; \
        _Pragma("unroll") for (int i = 0; i < 16; ++i) lfh[i] = LF[(t0n_ + 16 * seg + i) * 512 + h * 128 + kel]; \
        if (WITH_OUT) { _Pragma("unroll") for (int i = 0; i < 16; ++i) qav[i] = QA[(t0n_ + 16 * seg + i) * 512 + h * 128 + kel]; } \
        vg0 = *(const u32x4*)(HV + (t0n_ + vkv) * 512 + h * 128 + vch * 8); vg1 = *(const u32x4*)(HV + (t0n_ + vkv + 32) * 512 + h * 128 + vch * 8); } while (0)
    HG_LOADS(0);
    if (WITH_OUT) {
#pragma unroll
        for (int g = 0; g < 4; ++g) ngv[g] = *(const f32x4*)(NG + h * 128 + 32 * vb + 8 * g + 4 * hi);
    }
    for (int ch = 0; ch < 8; ++ch) {
        const size_t t0 = tok0 + ch * 64;
        float lfv[16], cum[16], qaf[16]; float csum = 0.f;
#pragma unroll
        for (int i = 0; i < 16; ++i) { lfv[i] = (float)lfh[i]; csum += lfv[i]; cum[i] = csum; if (WITH_OUT) qaf[i] = bf2f(qav[i]); }
        *(LAS u32x4*)(lds + HG_VT + vkv * HG_PV + vch * 16) = vg0; *(LAS u32x4*)(lds + HG_VT + (vkv + 32) * HG_PV + vch * 16) = vg1;
        if (WITH_OUT) {
#pragma unroll
            for (int g = 0; g < 4; ++g) gate[g] = *(const pg8::u32x2*)(HGp + (t0 + 32 * tb + r32) * 512 + h * 128 + 32 * vb + 8 * g + 4 * hi);
        }
        HG_LOADS(min(ch + 1, 7));
        segt[seg * 128 + kel] = csum;
        if (WITH_OUT) {
#pragma unroll
            for (int i = 0; i < 2; ++i) { const int kb = 2 * tb + i;
#pragma unroll
                for (int g = 0; g < 4; ++g) { pg8::u32x2 w; w.x = cvt_pk_bf16(st[i][4 * g], st[i][4 * g + 1]); w.y = cvt_pk_bf16(st[i][4 * g + 2], st[i][4 * g + 3]);
                    *(LAS pg8::u32x2*)(lds + HG_ST + (32 * vb + r32) * HG_PS + (32 * kb + 8 * g + 4 * hi) * 2) = w; } }
        }
        __syncthreads();
        float off = 0.f, blast = 0.f;
#pragma unroll
        for (int s2 = 0; s2 < 4; ++s2) { const float v = segt[s2 * 128 + kel]; blast += v; if (s2 < seg) off += v; }
        float kd[16];
#pragma unroll
        for (int i = 0; i < 16; ++i) { const float bc = off + cum[i]; const float kk = 1.0f - __expf(lfv[i]);
            if (WITH_OUT) { const int t = 16 * seg + i; const float qa = qaf[i];
                *(LAS bf16_t*)(lds + HG_QD + t * HG_PQ + kel * 2) = f2bf(qa * __expf(bc)); *(LAS bf16_t*)(lds + HG_KI + t * HG_PQ + kel * 2) = f2bf(kk * __expf(fminf(-bc, 80.0f))); }
            kd[i] = kk * __expf(blast - bc); }
        { u32x4 w0, w1; w0.x = cvt_pk_bf16(kd[0], kd[1]); w0.y = cvt_pk_bf16(kd[2], kd[3]); w0.z = cvt_pk_bf16(kd[4], kd[5]); w0.w = cvt_pk_bf16(kd[6], kd[7]);
          w1.x = cvt_pk_bf16(kd[8], kd[9]); w1.y = cvt_pk_bf16(kd[10], kd[11]); w1.z = cvt_pk_bf16(kd[12], kd[13]); w1.w = cvt_pk_bf16(kd[14], kd[15]);
          *(LAS u32x4*)(lds + HG_KDT + kel * HG_PT + seg * 32) = w0; *(LAS u32x4*)(lds + HG_KDT + kel * HG_PT + seg * 32 + 16) = w1; }
        if (seg == 0) { dvec[kel] = __expf(blast); ltot += blast; }
        __syncthreads();
        float ofin[16];
        bf16x8 vf[4];
#pragma unroll
        for (int s4 = 0; s4 < 4; ++s4) { LAS const unsigned char* vp = lds + HG_VT + (16 * s4 + 4 * hi + ((lane & 15) >> 2)) * HG_PV + 64 * vb + ((lane >> 4) & 1) * 32 + (lane & 3) * 8;
            const s16x4_t lo = lds_tr16(vp), hh = lds_tr16(vp + 8 * HG_PV); vf[s4] = (bf16x8){lo[0], lo[1], lo[2], lo[3], hh[0], hh[1], hh[2], hh[3]}; }
        if (WITH_OUT) {
            bf16x8 qd[8];
#pragma unroll
            for (int ks = 0; ks < 8; ++ks) qd[ks] = *(LAS const bf16x8*)(lds + HG_QD + (32 * tb + r32) * HG_PQ + (16 * ks + 8 * hi) * 2);
            f32x16 oacc;
#pragma unroll
            for (int r = 0; r < 16; ++r) oacc[r] = 0.f;
#pragma unroll
            for (int ks = 0; ks < 8; ++ks) { const bf16x8 sf = *(LAS const bf16x8*)(lds + HG_ST + (32 * vb + r32) * HG_PS + (16 * ks + 8 * hi) * 2);
                oacc = __builtin_amdgcn_mfma_f32_32x32x16_bf16(sf, qd[ks], oacc, 0, 0, 0); }
#pragma unroll
            for (int sb = 0; sb < 2; ++sb) {
                if (sb <= tb) {
                    f32x16 at;
#pragma unroll
                    for (int r = 0; r < 16; ++r) at[r] = 0.f;
#pragma unroll
                    for (int ks = 0; ks < 8; ++ks) { const bf16x8 kf = *(LAS const bf16x8*)(lds + HG_KI + (32 * sb + r32) * HG_PQ + (16 * ks + 8 * hi) * 2);
                        at = __builtin_amdgcn_mfma_f32_32x32x16_bf16(kf, qd[ks], at, 0, 0, 0); }
                    if (sb == tb) {
#pragma unroll
                        for (int r = 0; r < 16; ++r) if (crow(r, hi) > r32) at[r] = 0.f;
                    }
#pragma unroll
                    for (int s2 = 0; s2 < 2; ++s2) { u32x4 w; w.x = cvt_pk_bf16(at[8 * s2], at[8 * s2 + 1]); w.y = cvt_pk_bf16(at[8 * s2 + 2], at[8 * s2 + 3]); w.z = cvt_pk_bf16(at[8 * s2 + 4], at[8 * s2 + 5]); w.w = cvt_pk_bf16(at[8 * s2 + 6], at[8 * s2 + 7]);
                        oacc = __builtin_amdgcn_mfma_f32_32x32x16_bf16(vf[2 * sb + s2], __builtin_bit_cast(bf16x8, w), oacc, 0, 0, 0); }
                }
            }
            { float q2 = 0.f;
#pragma unroll
              for (int r = 0; r < 16; ++r) q2 += oacc[r] * oacc[r];
              q2 += __shfl_xor(q2, 32);
              if (hi == 0) ssq[(32 * tb + r32) * 4 + vb] = q2; }
#pragma unroll
            for (int r = 0; r < 16; ++r) ofin[r] = oacc[r];
        }
#pragma unroll
        for (int i = 0; i < 2; ++i) { const int kb = 2 * tb + i;
#pragma unroll
            for (int r = 0; r < 16; ++r) st[i][r] *= dvec[32 * kb + crow(r, hi)];
#pragma unroll
            for (int s4 = 0; s4 < 4; ++s4) { LAS const unsigned char* kp = lds + HG_KDT + (32 * kb + r32) * HG_PT + (16 * s4 + 4 * hi) * 2;
                const pg8::u32x2 a0 = *(LAS const pg8::u32x2*)kp, a1 = *(LAS const pg8::u32x2*)(kp + 16);
                const u32x4 aw = (u32x4){a0.x, a0.y, a1.x, a1.y};
                st[i] = __builtin_amdgcn_mfma_f32_32x32x16_bf16(__builtin_bit_cast(bf16x8, aw), vf[s4], st[i], 0, 0, 0); } }
        __syncthreads();
        if (WITH_OUT) {
            const f32x4 q4 = *(LAS const f32x4*)(ssq + (32 * tb + r32) * 4); const float rn = rsqrtf(((q4[0] + q4[1]) + (q4[2] + q4[3])) * (1.0f / 128.0f) + 1e-6f);
#pragma unroll
            for (int g = 0; g < 4; ++g) { const f32x4 gn = ngv[g]; const pg8::u32x2 gw = gate[g];
                const float g0 = __uint_as_float(gw.x << 16), g1 = __uint_as_float(gw.x & 0xffff0000u), g2 = __uint_as_float(gw.y << 16), g3 = __uint_as_float(gw.y & 0xffff0000u);
                pg8::u32x2 w; w.x = cvt_pk_bf16(ofin[4 * g] * rn * gn[0] * g0, ofin[4 * g + 1] * rn * gn[1] * g1); w.y = cvt_pk_bf16(ofin[4 * g + 2] * rn * gn[2] * g2, ofin[4 * g + 3] * rn * gn[3] * g3);
                *(pg8::u32x2*)(OAp + (t0 + 32 * tb + r32) * 512 + h * 128 + 32 * vb + 8 * g + 4 * hi) = w; }
        }
    }
#undef HG_LOADS
    if (!WITH_OUT) {
#pragma unroll
        for (int i = 0; i < 2; ++i)
#pragma unroll
            for (int g = 0; g < 4; ++g) *(f32x4*)(U + (((((size_t)unit * 8 + wid) * 2 + i) * 4 + g) * 64 + lane) * 4) = (f32x4){st[i][4 * g], st[i][4 * g + 1], st[i][4 * g + 2], st[i][4 * g + 3]};
        if (seg == 0) DTOT[unit * 128 + kel] = __expf(ltot);
    }
}

DEVINL void phase_ln1_router(const Args& a, unsigned char* ws, LAS unsigned char* lds, int G) {
    const int tid = opaque_tid(), lane = tid & 63, wid = tid >> 6;
    const bf16_t* Y1 = (const bf16_t*)(ws + OFF_Y1); const float* g = a.in[9]; const float* bta = a.in[10]; const float* rw = a.in[11]; const float* rb = a.in[12];
    bf16_t* H1 = (bf16_t*)(ws + OFF_H1); bf16_t* H1B = (bf16_t*)(ws + OFF_H1B); int* counts = (int*)(ws + CTL_OFF);
    int* ltok = (int*)(ws + OFF_LTOK); float* lw = (float*)(ws + OFF_LW); int* toke = (int*)(ws + OFF_TOKE); int* tokr = (int*)(ws + OFF_TOKR);
    LAS unsigned char* rwl = lds;
    LAS float* tl = (LAS float*)(lds + LDSCTL_OFF + 64) + wid * 528;
    __syncthreads();
#pragma unroll 2
    for (int ps = 0; ps < 8; ++ps) { const int e = tid & 31, kb = ps * 16 + (tid >> 5);
        float v[8], l[8]; unsigned wh[4], wl[4];
#pragma unroll
        for (int j = 0; j < 8; ++j) v[j] = rw[(8 * kb + j) * 32 + e];
#pragma unroll
        for (int j = 0; j < 4; ++j) { wh[j] = cvt_pk_bf16(v[2 * j], v[2 * j + 1]); l[2 * j] = v[2 * j] - __uint_as_float(wh[j] << 16); l[2 * j + 1] = v[2 * j + 1] - __uint_as_float(wh[j] & 0xffff0000u); }
#pragma unroll
        for (int j = 0; j < 4; ++j) wl[j] = cvt_pk_bf16(l[2 * j], l[2 * j + 1]);
        const int off = ((((e >> 4) * 32 + (kb >> 2)) * 4 + (kb & 3)) * 16 + (e & 15)) * 16;
        *(LAS u32x4*)(rwl + off) = (u32x4){wh[0], wh[1], wh[2], wh[3]}; *(LAS u32x4*)(rwl + 65536 + off) = (u32x4){wl[0], wl[1], wl[2], wl[3]}; }
    __syncthreads();
    const int i16 = lane & 15, kq = lane >> 4;
    LAS int* hist = (LAS int*)(lds + LDSCTL_OFF + 64 + 8 * 528 * 4); LAS int* wbase = hist + 32;
    if (tid < 32) hist[tid] = 0;
    __syncthreads();
    const int nrounds = (NTOK / 16 + G * 8 - 1) / (G * 8);
    for (int round = 0; round < nrounds; ++round) {
        const int tile = round * G * 8 + blockIdx.x * 8 + wid; const bool active = tile < NTOK / 16;
        int ti[4] = {0, 0, 0, 0}, lrank[4] = {0, 0, 0, 0}; float wsn[4] = {0.f, 0.f, 0.f, 0.f};
        const int row0 = tile * 16;
        if (active) {
        {
            const f32x4* g4 = (const f32x4*)g + lane; const f32x4* b4 = (const f32x4*)bta + lane;
            pg8::u32x2 ynA[2][4], ynB[2][4];
#define LN1_LOAD(YN, RP) do { _Pragma("unroll") for (int r = 0; r < 2; ++r) _Pragma("unroll") for (int j = 0; j < 4; ++j) YN[r][j] = ((const pg8::u32x2*)(Y1 + (size_t)(row0 + 2 * (RP) + r) * DM))[lane + 64 * j]; } while (0)
#define LN1_PAIR(YN, RP, RPN) do { f32x4 y[2][4]; \
                _Pragma("unroll") for (int r = 0; r < 2; ++r) _Pragma("unroll") for (int j = 0; j < 4; ++j) { const pg8::u32x2 w = YN[r][j]; y[r][j] = (f32x4){__uint_as_float(w.x << 16), __uint_as_float(w.x & 0xffff0000u), __uint_as_float(w.y << 16), __uint_as_float(w.y & 0xffff0000u)}; } \
                LN1_LOAD(YN, RPN); \
                _Pragma("unroll") for (int r = 0; r < 2; ++r) { const size_t row = row0 + 2 * (RP) + r; float s_ = 0.f; \
                    _Pragma("unroll") for (int j = 0; j < 4; ++j) s_ += (y[r][j][0] + y[r][j][1]) + (y[r][j][2] + y[r][j][3]); \
                    const float mean = wave_sum(s_) * (1.0f / 1024.0f); float q = 0.f; \
                    _Pragma("unroll") for (int j = 0; j < 4; ++j) { y[r][j] = y[r][j] - mean; q += (y[r][j][0] * y[r][j][0] + y[r][j][1] * y[r][j][1]) + (y[r][j][2] * y[r][j][2] + y[r][j][3] * y[r][j][3]); } \
                    const float rstd = rsqrtf(wave_sum(q) * (1.0f / 1024.0f) + 1e-5f); \
                    _Pragma("unroll") for (int j = 0; j < 4; ++j) { const f32x4 hv = y[r][j] * rstd * g4[64 * j] + b4[64 * j]; \
                        { pg8::u32x2 w; w.x = cvt_pk_bf16(hv[0], hv[1]); w.y = cvt_pk_bf16(hv[2], hv[3]); ((pg8::u32x2*)(H1 + row * DM))[lane + 64 * j] = w; } \
                        ((unsigned*)((unsigned char*)H1B + row * DM))[lane + 64 * j] = pk4_fp8(hv[0], hv[1], hv[2], hv[3]); } } } while (0)
            LN1_LOAD(ynA, 0); LN1_LOAD(ynB, 1);
#pragma unroll 1
            for (int it = 0; it < 4; ++it) { const int rpa = min(2 * it + 2, 7), rpb = min(2 * it + 3, 7);
                LN1_PAIR(ynA, 2 * it, rpa); LN1_PAIR(ynB, 2 * it + 1, rpb); }
#undef LN1_LOAD
#undef LN1_PAIR
        }
        asm volatile("s_waitcnt vmcnt(0)" ::: "memory");
        f32x4 acc0 = (f32x4){0.f, 0.f, 0.f, 0.f}, acc1 = (f32x4){0.f, 0.f, 0.f, 0.f};
        const bf16_t* hrow = H1 + (size_t)(row0 + i16) * DM + 8 * kq;
        LAS const unsigned char* bp0 = rwl + (kq * 16 + i16) * 16;
        bf16x8 afr[32];
#pragma unroll
        for (int st = 0; st < 32; ++st) afr[st] = *(const bf16x8*)(hrow + 32 * st);
#pragma unroll
        for (int st = 0; st < 32; ++st) {
            const bf16x8 af = afr[st];
            LAS const unsigned char* bp = bp0 + st * 1024;
            const bf16x8 b0h = *(LAS const bf16x8*)bp, b1h = *(LAS const bf16x8*)(bp + 32768), b0l = *(LAS const bf16x8*)(bp + 65536), b1l = *(LAS const bf16x8*)(bp + 65536 + 32768);
            acc0 = __builtin_amdgcn_mfma_f32_16x16x32_bf16(af, b0h, acc0, 0, 0, 0); acc1 = __builtin_amdgcn_mfma_f32_16x16x32_bf16(af, b1h, acc1, 0, 0, 0);
            acc0 = __builtin_amdgcn_mfma_f32_16x16x32_bf16(af, b0l, acc0, 0, 0, 0); acc1 = __builtin_amdgcn_mfma_f32_16x16x32_bf16(af, b1l, acc1, 0, 0, 0); }
        const float rb0 = rb[i16], rb1 = rb[16 + i16];
#pragma unroll
        for (int rg = 0; rg < 4; ++rg) { tl[(4 * kq + rg) * 33 + i16] = acc0[rg] + rb0; tl[(4 * kq + rg) * 33 + 16 + i16] = acc1[rg] + rb1; }
        asm volatile("s_waitcnt lgkmcnt(0)" ::: "memory");
        if (lane < 16) {
            const int row = row0 + lane;
            float lg[32];
#pragma unroll
            for (int e = 0; e < 32; ++e) lg[e] = tl[lane * 33 + e];
            unsigned taken = 0u; float tv[4];
#pragma unroll
            for (int k = 0; k < 4; ++k) { float best = -INFINITY; int bi = 0;
#pragma unroll
                for (int e = 0; e < 32; ++e) { const bool ok = !((taken >> e) & 1u) && lg[e] > best; best = ok ? lg[e] : best; bi = ok ? e : bi; }
                taken |= 1u << bi; tv[k] = best; ti[k] = bi; }
            float den = 0.f;
#pragma unroll
            for (int k = 0; k < 4; ++k) { wsn[k] = expf(tv[k] - tv[0]); den += wsn[k]; }
#pragma unroll
            for (int k = 0; k < 4; ++k) { wsn[k] /= den; lrank[k] = __hip_atomic_fetch_add((int*)(hist + ti[k]), 1, __ATOMIC_RELAXED, __HIP_MEMORY_SCOPE_WORKGROUP); }
        }
        }
        __syncthreads();
        if (tid < 32) { const int c = hist[tid]; wbase[tid] = c ? atomicAdd(&counts[tid], c) : 0; }
        __syncthreads();
        if (active && lane < 16) { const int row = row0 + lane;
#pragma unroll
            for (int k = 0; k < 4; ++k) { const int e = ti[k]; const int rank = wbase[e] + lrank[k];
                ltok[(size_t)e * NTOK + rank] = row; lw[row * 4 + k] = wsn[k]; toke[row * 4 + k] = e; tokr[row * 4 + k] = rank; } }
        __syncthreads();
        if (tid < 32) hist[tid] = 0;
        __syncthreads();
    }
}
DEVINL void phase_ln2(const Args& a, unsigned char* ws, int G) {
    const int tid = opaque_tid(), lane = tid & 63;
    const bf16_t* H1 = (const bf16_t*)(ws + OFF_H1); const unsigned char* Y2 = (const unsigned char*)(ws + OFF_Y2); const int* counts = (const int*)(ws + CTL_OFF);
    const int* toke = (const int*)(ws + OFF_TOKE); const int* tokr = (const int*)(ws + OFF_TOKR); float* out = a.out; const float* lwt = (const float*)(ws + OFF_LW);
    const f32x4* g4 = (const f32x4*)a.in[17] + lane; const f32x4* b4 = (const f32x4*)a.in[18] + lane;
    int pad = lane < 32 ? ((counts[lane] + 255) >> 8) : 0; int incl = pad;
    for (int d = 1; d < 32; d <<= 1) { const int t = __shfl_up(incl, d); if (lane >= d) incl += t; }
    const int excl = (incl - pad) * 256;
    const int NW = G * 8;
    for (int row0 = blockIdx.x * 8 + (tid >> 6); row0 < NTOK; row0 += 2 * NW) {
        const int rows[2] = {row0, row0 + NW};
        int4 te[2], tr[2]; f32x4 tw[2];
#pragma unroll
        for (int u = 0; u < 2; ++u) { const int r = rows[u] < NTOK ? rows[u] : row0; te[u] = *(const int4*)(toke + r * 4); tr[u] = *(const int4*)(tokr + r * 4); tw[u] = *(const f32x4*)(lwt + r * 4); }
        f32x4 y[2][4]; unsigned yv[2][4][4];
#pragma unroll
        for (int u = 0; u < 2; ++u) { const int r = rows[u] < NTOK ? rows[u] : row0;
            size_t arow[4];
            arow[0] = (size_t)(__shfl(excl, te[u].x) + tr[u].x); arow[1] = (size_t)(__shfl(excl, te[u].y) + tr[u].y); arow[2] = (size_t)(__shfl(excl, te[u].z) + tr[u].z); arow[3] = (size_t)(__shfl(excl, te[u].w) + tr[u].w);
#pragma unroll
            for (int j = 0; j < 4; ++j) { { const pg8::u32x2 hw = ((const pg8::u32x2*)(H1 + (size_t)r * DM))[lane + 64 * j]; y[u][j] = (f32x4){__uint_as_float(hw.x << 16), __uint_as_float(hw.x & 0xffff0000u), __uint_as_float(hw.y << 16), __uint_as_float(hw.y & 0xffff0000u)}; }
#pragma unroll
                for (int k = 0; k < 4; ++k) yv[u][k][j] = ((const unsigned*)(Y2 + arow[k] * DM))[lane + 64 * j]; } }
#pragma unroll
        for (int u = 0; u < 2; ++u) { if (rows[u] >= NTOK) continue;
            float s_ = 0.f;
#pragma unroll
            for (int j = 0; j < 4; ++j) { f32x4 v = y[u][j] * DN_ALPHA;
#pragma unroll
                for (int k = 0; k < 4; ++k) { const unsigned w = yv[u][k][j]; const float tk = tw[u][k] * (1.0f / Y2_SCALE); const pg8::f32x2 lo = __builtin_amdgcn_cvt_pk_f32_fp8((int)w, false), hh = __builtin_amdgcn_cvt_pk_f32_fp8((int)w, true);
                    v[0] += tk * lo.x; v[1] += tk * lo.y; v[2] += tk * hh.x; v[3] += tk * hh.y; }
                y[u][j] = v; s_ += (v[0] + v[1]) + (v[2] + v[3]); }
            const float mean = wave_sum(s_) * (1.0f / 1024.0f); float q = 0.f;
#pragma unroll
            for (int j = 0; j < 4; ++j) { y[u][j] = y[u][j] - mean; q += (y[u][j][0] * y[u][j][0] + y[u][j][1] * y[u][j][1]) + (y[u][j][2] * y[u][j][2] + y[u][j][3] * y[u][j][3]); }
            const float rstd = rsqrtf(wave_sum(q) * (1.0f / 1024.0f) + 1e-5f);
#pragma unroll
            for (int j = 0; j < 4; ++j) ((f32x4*)(out + (size_t)rows[u] * DM))[lane + 64 * j] = y[u][j] * rstd * g4[64 * j] + b4[64 * j]; }
    }
}
DEVINL int build_tile_table(LAS unsigned char* ldsctl, const int* counts) {
    LAS int* pre = (LAS int*)(ldsctl + LC_PRE); LAS int* tab = (LAS int*)(ldsctl + LC_TAB);
    __syncthreads();
    if (threadIdx.x == 0) { int s = 0; for (int e = 0; e < NEXP; ++e) { pre[e] = s; s += (counts[e] + 255) >> 8; } pre[NEXP] = s; }
    __syncthreads();
    const int nT = pre[NEXP];
    for (int t = threadIdx.x; t < nT; t += 512) { int e = 0; for (int k = 1; k < NEXP; ++k) if (pre[k] <= t) e = k; tab[t] = e | ((t - pre[e]) << 8); }
    __syncthreads();
    return nT;
}

__global__ void __launch_bounds__(512, 2) mk_fwd(Args args) {
    extern __shared__ __attribute__((aligned(16))) unsigned char lds_raw[];
    LAS unsigned char* lds = (LAS unsigned char*)lds_raw;
    LAS unsigned char* ldsctl = lds + LDSCTL_OFF;
    const int tid = threadIdx.x; const int G = gridDim.x;
    unsigned char* ws = args.ws;
    for (int u = tid; u < (LDS_BYTES - LDSCTL_OFF) / 4; u += 512) ((LAS unsigned*)ldsctl)[u] = 0u;
    __syncthreads();
    XcdBarrier bar = xcd_barrier_post((unsigned*)(ws + CTL_OFF + CTL_BAR) + args.li * XCD_BAR_WORDS, (volatile LAS unsigned*)(ldsctl + LC_MISC) + 8);
    const int lo = args.ph_lo, hi = args.ph_hi;
    const int* counts = (const int*)(ws + CTL_OFF);
#ifndef PHMASK
#define PHMASK 0xFFFF
#endif
#define IN(k) (((PHMASK >> (k)) & 1) && lo <= (k) && (k) < hi)
#define BOTH(k) (IN(k) && IN((k) + 1))
#define GRID_BAR() xcd_barrier(bar)

    if (IN(PH_PRO)) { phase_prologue(args, ws, lds, G); if (BOTH(PH_PRO)) GRID_BAR(); }
    if (IN(PH_INPROJ)) {
        { pg8::PlainOrder<1024> S{(const char*)(ws + OFF_XB), (const char*)(ws + OFF_WIN), NTOK / 256, 12, G, (int)blockIdx.x};
          EpiInproj<false> E{ws, (const float*)(ws + OFF_SMALL)};
          pg8::gemm_phase<1024, false>(lds, S, E); }
        { pg8::PlainOrder<512> S{(const char*)(ws + OFF_XB8), (const char*)(ws + OFF_WIN8), NTOK / 256, 10, G, (int)blockIdx.x};
          EpiInproj<true> E{ws, (const float*)(ws + OFF_SMALL)};
          pg8::gemm_phase<512, false, EpiInproj<true>, pg8::PlainOrder<512>, true>(lds, S, E); }
        if (BOTH(PH_INPROJ)) GRID_BAR();
    }
    if (IN(PH_HGA)) {
        for (int u = blockIdx.x; u < 256; u += G) hgrn_unit<false>(u, (const bf16_t*)(ws + OFF_QA), (const _Float16*)(ws + OFF_LF), (const bf16_t*)(ws + OFF_HV), (const bf16_t*)(ws + OFF_HG), args.in[3], (bf16_t*)(ws + OFF_OA), (float*)(ws + OFF_U), (float*)(ws + OFF_DTOT), lds);
        {
            const int t_ = opaque_tid(), ln_ = t_ & 63, wv_ = t_ >> 6; const bf16_t* DKp = (const bf16_t*)(ws + OFF_DK);
            for (int rb = blockIdx.x; rb < NTOK / 128; rb += G) { float mx = 0.f;
                for (int r = 0; r < 16; ++r) { const size_t row = (size_t)rb * 128 + wv_ * 16 + r;
                    const u32x4 w = *(const u32x4*)(DKp + row * 512 + ln_ * 8); const f32x4 lo = bf4_lo(w), hi4 = bf4_hi(w);
                    float q2 = (lo[0] * lo[0] + lo[1] * lo[1]) + (lo[2] * lo[2] + lo[3] * lo[3]) + (hi4[0] * hi4[0] + hi4[1] * hi4[1]) + (hi4[2] * hi4[2] + hi4[3] * hi4[3]);
                    q2 += __shfl_xor(q2, 1); q2 += __shfl_xor(q2, 2); q2 += __shfl_xor(q2, 4); mx = fmaxf(mx, q2); }
                if ((ln_ & 7) == 0) atomicMax((unsigned*)(ws + CTLX_OFF) + 128 + (rb * 128 / SEQ) * 8 + (ln_ >> 3), __float_as_uint(mx)); }
        }
        if (BOTH(PH_HGA)) GRID_BAR();
    }
    if (IN(PH_ATT)) {
        for (int u = blockIdx.x; u < 256; u += G) hgrn_unit<true>(u, (const bf16_t*)(ws + OFF_QA), (const _Float16*)(ws + OFF_LF), (const bf16_t*)(ws + OFF_HV), (const bf16_t*)(ws + OFF_HG), args.in[3], (bf16_t*)(ws + OFF_OA), (float*)(ws + OFF_U), (float*)(ws + OFF_DTOT), lds);
        __syncthreads();
        attn_phase(args, ws, lds, G);
        __syncthreads();
        if (BOTH(PH_ATT)) GRID_BAR();
    }
    if (IN(PH_BRANCH)) {
        { BranchOrder S{(const char*)(ws + OFF_OA), (const char*)(ws + OFF_OB), (const char*)(ws + OFF_WA), (const char*)(ws + OFF_WB), NTOK / 256, DM / 256, G, (int)blockIdx.x};
          EpiBranchChain E{(const bf16_t*)(ws + OFF_GA), (const bf16_t*)(ws + OFF_GB), (bf16_t*)(ws + OFF_MERGED)};
          pg8::gemm_phase<512, false>(lds, S, E); }
        if (BOTH(PH_BRANCH)) GRID_BAR();
    }
    if (IN(PH_OUT)) {
        pg8::PlainOrder<1024> S{(const char*)(ws + OFF_MERGED), (const char*)(ws + OFF_WOUT), NTOK / 256, DM / 256, G, (int)blockIdx.x};
        EpiOut E{args.in[0], (bf16_t*)(ws + OFF_Y1)};
        pg8::gemm_phase<1024, false>(lds, S, E);
        if (BOTH(PH_OUT)) GRID_BAR();
    }
    if (IN(PH_LN1)) { phase_ln1_router(args, ws, lds, G); if (BOTH(PH_LN1)) GRID_BAR(); }
    if (IN(PH_GU)) {
        const int nT = build_tile_table(ldsctl, counts);
        MoeOrder<512, true> S{(const LAS int*)(ldsctl + LC_TAB), nT, 8, G, (int)blockIdx.x, (const char*)(ws + OFF_H1B), (const char*)(ws + OFF_WGU), counts, (const int*)(ws + OFF_LTOK)};
        EpiGU8 E{args.in[14], (unsigned char*)(ws + OFF_ACT)};
        pg8::gemm_phase<512, true, EpiGU8, MoeOrder<512, true>, true>(lds, S, E);
        if (BOTH(PH_GU)) GRID_BAR();
    }
    if (IN(PH_DOWN)) {
        const int nT = build_tile_table(ldsctl, counts);
        MoeOrder<512, false> S{(const LAS int*)(ldsctl + LC_TAB), nT, 4, G, (int)blockIdx.x, (const char*)(ws + OFF_ACT), (const char*)(ws + OFF_WD), counts, nullptr};
        EpiDown8 E{args.in[16], (unsigned char*)(ws + OFF_Y2)};
        pg8::gemm_phase<512, false, EpiDown8, MoeOrder<512, false>, true>(lds, S, E);
        if (BOTH(PH_DOWN)) GRID_BAR();
    }
    if (IN(PH_LN2)) { phase_ln2(args, ws, G); }
#undef IN
#undef BOTH
#undef GRID_BAR
}

static void launch_mk(const Args& base, int lo, int hi, int li, int grid, hipStream_t stream) {
    Args a = base; a.ph_lo = lo; a.ph_hi = hi; a.li = li; a.pad = 0;
    hipLaunchKernelGGL(mk_fwd, dim3(grid), dim3(512), LDS_BYTES, stream, a);
}

extern "C" void kernel_launch(void* const* d_in, const int* in_sizes, int n_in, void* d_out, int out_size, void* d_ws, size_t ws_size, hipStream_t stream) {
    if (ws_size < WS_NEED || n_in < 19) return;
    static int grid = 0;
    if (grid == 0) {
        int dev = 0, cus = 0;
        if (hipGetDevice(&dev) != hipSuccess || hipDeviceGetAttribute(&cus, hipDeviceAttributeMultiprocessorCount, dev) != hipSuccess || cus <= 0) cus = 256;
        (void)hipFuncSetAttribute((const void*)mk_fwd, hipFuncAttributeMaxDynamicSharedMemorySize, LDS_BYTES);
        (void)hipGetLastError();
        grid = cus;
    }
    Args base{}; for (int i = 0; i < 19; ++i) base.in[i] = (const float*)d_in[i]; base.out = (float*)d_out; base.ws = (unsigned char*)d_ws;
    (void)hipMemsetAsync((unsigned char*)d_ws + CTL_OFF, 0, CTL_BYTES, stream);
    launch_mk(base, PH_PRO, PH_END, 0, grid, stream);
}
```

```cpp
#include <hip/hip_runtime.h>
#include <stdint.h>
#include <math.h>

#define DEVINL __device__ __forceinline__
typedef unsigned short bf16_t;
typedef short bf16x8 __attribute__((ext_vector_type(8)));
typedef float f32x4 __attribute__((ext_vector_type(4)));

constexpr int NTOK = 32768, DM = 1024, SEQ = 4096;
constexpr int DIN = 5632;
constexpr int NEXP = 32, DFF = 1024;
constexpr float DN_ALPHA = 1.189207115002721f;
constexpr float LAMBDA_INIT = 0.2f;

constexpr size_t MiB = 1ull << 20;
constexpr size_t OFF_QA = 0 * MiB, OFF_LF = 32 * MiB, OFF_HV = 96 * MiB, OFF_HG = 128 * MiB, OFF_DQ = 160 * MiB, OFF_DK = 192 * MiB, OFF_DV = 224 * MiB,
                 OFF_GA = 256 * MiB, OFF_GB = 320 * MiB, OFF_XB = 384 * MiB, OFF_U = 448 * MiB, OFF_OA = 480 * MiB, OFF_OJ = 512 * MiB, OFF_OB = 576 * MiB,
                 OFF_MERGED = 608 * MiB, OFF_WGU = 672 * MiB, OFF_WD = 800 * MiB, OFF_WIN = 864 * MiB, OFF_WA = 875 * MiB, OFF_WB = 876 * MiB, OFF_WOUT = 877 * MiB,
                 OFF_H1 = 879 * MiB, OFF_LTOK = 1007 * MiB, OFF_LW = 1011 * MiB, OFF_TOKE = 1015 * MiB, OFF_TOKR = 1015 * MiB + 512 * 1024, OFF_SMALL = 1016 * MiB,
                 WS_NEED = 1017 * MiB;
constexpr size_t OFF_XB8 = 448 * MiB  , OFF_WIN8 = 870 * MiB  ;
constexpr size_t OFF_Y1 = 0, OFF_Y2 = 0, OFF_H1B = 272 * MiB, OFF_ACT = 384 * MiB, OFF_OARAW = 879 * MiB;
constexpr size_t SMALL_CNT = 4096;

DEVINL float bf2f(bf16_t v) { return __uint_as_float(((unsigned)v) << 16); }
DEVINL bf16_t f2bf(float f) { unsigned u = __float_as_uint(f); return (bf16_t)((u + 0x7fffu + ((u >> 16) & 1u)) >> 16); }
DEVINL float sigmoidf_(float x) { return 1.0f / (1.0f + expf(-x)); }
DEVINL float wave_sum(float v) { for (int m = 32; m >= 1; m >>= 1) v += __shfl_xor(v, m); return v; }

namespace pg8 {
#define PG8_LAS __attribute__((address_space(3)))
typedef unsigned u32x4 __attribute__((ext_vector_type(4)));
typedef unsigned u32x2 __attribute__((ext_vector_type(2)));
typedef float f32x2 __attribute__((ext_vector_type(2)));
constexpr int BM = 256, BK = 64, HALF = 128, HTB = HALF * BK * 2, STAGE_BYTES = 8 * HTB, NXCD = 8, WGM = 8;
__host__ __device__ __forceinline__ int lds_byte(int r, int c) { const int st = (r >> 4) * 2 + (c >> 5), rr = r & 15, cc = c & 31, ob = rr * 64 + cc * 2; return st * 1024 + (ob ^ (((ob >> 9) & 1) << 5)); }
__host__ __device__ __forceinline__ void stage_rc(int b, int& R, int& C) { const int st = b / 1024, sb = b % 1024, swz = sb ^ (((sb >> 9) & 1) << 5); R = (st >> 1) * 16 + swz / 64; C = (st & 1) * 32 + (swz % 64) / 2; }
__host__ __device__ __forceinline__ int perm32(int rho) { const int n = rho >> 4, i = rho & 15; return 8 * (i >> 2) + 4 * n + (i & 3); }
typedef float f32x2_t __attribute__((ext_vector_type(2))); typedef __bf16 bf16x2_t __attribute__((ext_vector_type(2)));
__device__ __forceinline__ unsigned cvt_pk_bf16(float lo, float hi) { f32x2_t v = {lo, hi}; bf16x2_t b = __builtin_convertvector(v, bf16x2_t); return __builtin_bit_cast(unsigned, b); }

struct Unit { int pm, pn, e, r0, ui; };

template <int WGMT = WGM> __device__ __forceinline__ void order_decode(long L, int nM, int nN, int& pm, int& pn) {
    const int nwg = nM * nN; int wgid = (int)L;
    { const int q = nwg / NXCD, r = nwg % NXCD, xcd = wgid % NXCD, off = wgid / NXCD; wgid = (xcd < r ? xcd * (q + 1) : r * (q + 1) + (xcd - r) * q) + off; }
    const int nig = WGMT * nN, gid = wgid / nig, fm = gid * WGMT, gsz = (nM - fm) < WGMT ? (nM - fm) : WGMT;
    pm = fm + ((wgid % nig) % gsz); pn = (wgid % nig) / gsz;
}
template <int K> struct PlainOrder {
    const char* A; const char* Bt; int nM, nN, G, c;
    __device__ __forceinline__ bool next(int i, Unit& u) const { const long L = (long)i * G + c; if (L >= (long)nM * nN) return false; order_decode(L, nM, nN, u.pm, u.pn); u.e = 0; u.r0 = 0; return true; }
    __device__ __forceinline__ const char* a_base(const Unit& u) const { return A + (size_t)u.pm * (256 * K * 2); }
    __device__ __forceinline__ const char* b_base(const Unit& u) const { return Bt + (size_t)u.pn * (256 * K * 2); }
    __device__ __forceinline__ void a_offsets(const Unit&, const int (&Rl)[2], const int (&Cl)[2], unsigned (&off)[2][2]) const {
#pragma unroll
        for (int h = 0; h < 2; ++h)
#pragma unroll
            for (int i = 0; i < 2; ++i) off[h][i] = (unsigned)((h * HALF + Rl[i]) * K + Cl[i]) * 2u;
    }
};

typedef int i32x4v __attribute__((ext_vector_type(4))); typedef int i32x8v __attribute__((ext_vector_type(8)));
template <class E> struct EpiWide { static constexpr bool value = false; };
template <class E> struct EpiWide2 { static constexpr bool value = false; };
template <class E> struct EpiChain { static constexpr bool value = false; };
template <bool F8> struct OperandT;
template <> struct OperandT<false> { struct type { bf16x8 k0, k1; };
    static __device__ __forceinline__ void load(type& d, PG8_LAS const unsigned char* p) { d.k0 = *(const PG8_LAS bf16x8*)p; d.k1 = *(const PG8_LAS bf16x8*)(p + 1024); }
    static __device__ __forceinline__ f32x4 mma(const type& b, const type& a, f32x4 c) { c = __builtin_amdgcn_mfma_f32_16x16x32_bf16(b.k0, a.k0, c, 0, 0, 0); return __builtin_amdgcn_mfma_f32_16x16x32_bf16(b.k1, a.k1, c, 0, 0, 0); } };
template <> struct OperandT<true> { typedef i32x8v type;
    static __device__ __forceinline__ void load(type& d, PG8_LAS const unsigned char* p) { const i32x4v lo = *(const PG8_LAS i32x4v*)p, hi = *(const PG8_LAS i32x4v*)(p + 1024); d = __builtin_shufflevector(lo, hi, 0, 1, 2, 3, 4, 5, 6, 7); }
    static __device__ __forceinline__ f32x4 mma(const type& b, const type& a, f32x4 c) { const int sc = 0x7f7f7f7f;
        asm volatile("v_mfma_scale_f32_16x16x128_f8f6f4 %0, %1, %2, %0, %3, %3 op_sel_hi:[0,0,0]" : "+v"(c) : "v"(b), "v"(a), "v"(sc)); return c; } };
template <int K, bool GATHER, class Epi, class Sched, bool F8 = false>
__device__ __forceinline__ void gemm_phase(PG8_LAS unsigned char* lds, const Sched& S, const Epi& E) {
    int tid_ = threadIdx.x; asm volatile("" : "+v"(tid_));
    const int tid = tid_, wid = __builtin_amdgcn_readfirstlane(tid >> 6), lane = tid & 63, wr = wid >> 2, wc = wid & 3, fr = lane & 15, fq = lane >> 4;
    constexpr int nt = K / BK;
    int Rl[2], Cl[2]; unsigned voffB[2][2];
#pragma unroll
    for (int i = 0; i < 2; ++i) { int R, C; stage_rc(tid * 16 + i * 8192, R, C); Rl[i] = R; Cl[i] = C;
#pragma unroll
        for (int h = 0; h < 2; ++h) { int Rb;
            if (EpiWide2<Epi>::value) Rb = 64 * (R >> 5) + 32 * h + 8 * ((R & 15) >> 2) + 4 * ((R >> 4) & 1) + (R & 3);
            else if (EpiWide<Epi>::value) Rb = 64 * (R >> 5) + 16 * ((R & 15) >> 2) + 8 * h + 4 * ((R >> 4) & 1) + (R & 3);
            else Rb = h * HALF + (Epi::PERM ? ((R & ~31) + perm32(R & 31)) : R);
            voffB[h][i] = (unsigned)(Rb * K + C) * 2u; } }
    unsigned voffA[2][2], voffAn[2][2];
    constexpr size_t kstep = (size_t)(BK * 2);
    constexpr size_t hstep = (size_t)HALF * K * 2;
    const unsigned ldsw = (unsigned)wid * 1024u;
    const int aoff = lds_byte(wr * 64 + fr, fq * 8), boff = lds_byte(wc * 32 + fr, fq * 8);
#define PG8_SA(b, h) (((b) * 2 + (h)) * HTB)
#define PG8_SB(b, h) ((4 + (b) * 2 + (h)) * HTB)
#define PG8_STAGE(bufoff, gbase, voff) do { _Pragma("unroll") for (int _i = 0; _i < 2; ++_i) \
        __builtin_amdgcn_global_load_lds((const unsigned*)((const char*)(gbase) + (voff)[_i]), (PG8_LAS unsigned*)(lds + (bufoff) + ldsw + _i * 8192), 16, 0, 0); } while (0)
#define PG8_LDA(dst, b, h) do { _Pragma("unroll") for (int m = 0; m < 4; ++m) OperandT<F8>::load(dst[m], lds + PG8_SA(b, h) + aoff + m * 2048); } while (0)
#define PG8_LDB(dst, b, h) do { _Pragma("unroll") for (int n = 0; n < 2; ++n) OperandT<F8>::load(dst[n], lds + PG8_SB(b, h) + boff + n * 2048); } while (0)
#define PG8_MMA(ai, bj, At, Bt) do { __builtin_amdgcn_s_setprio(1); _Pragma("unroll") for (int m = 0; m < 4; ++m) { \
        acc8[ai][bj][m].lo = OperandT<F8>::mma(Bt[0], At[m], acc8[ai][bj][m].lo); acc8[ai][bj][m].hi = OperandT<F8>::mma(Bt[1], At[m], acc8[ai][bj][m].hi); } __builtin_amdgcn_s_setprio(0); } while (0)
#define PG8_WAIT_V(n) asm volatile("s_waitcnt vmcnt(" #n ")" ::: "memory")
#define PG8_WAIT_L(n) asm volatile("s_waitcnt lgkmcnt(" #n ")" ::: "memory")
#define PG8_BAR __builtin_amdgcn_s_barrier()
#define PG8_SCHED __builtin_amdgcn_sched_barrier(0)
    Unit cur, nxt; int ui = 0;
    if (!S.next(0, cur)) return;
    typedef float f32x8v __attribute__((ext_vector_type(8)));
    f32x8v acc8[2][2][4];
#pragma unroll
    for (int a = 0; a < 2; ++a)
#pragma unroll
        for (int b = 0; b < 2; ++b)
#pragma unroll
            for (int m = 0; m < 4; ++m) acc8[a][b][m] = (f32x8v){0.f, 0.f, 0.f, 0.f, 0.f, 0.f, 0.f, 0.f};
    typename OperandT<F8>::type At[4], B0[2], B1[2];
    const char* cA = S.a_base(cur); const char* cB = S.b_base(cur);
    S.a_offsets(cur, Rl, Cl, voffA);
    PG8_STAGE(PG8_SB(0, 0), cB, voffB[0]); PG8_STAGE(PG8_SB(0, 1), cB, voffB[1]); PG8_STAGE(PG8_SA(0, 0), cA, voffA[0]); PG8_STAGE(PG8_SA(0, 1), cA, voffA[1]);
    if (wr == 1) PG8_BAR;
    PG8_WAIT_V(2); PG8_BAR;
    PG8_STAGE(PG8_SB(1, 0), cB + kstep, voffB[0]); PG8_STAGE(PG8_SA(1, 0), cA + kstep, voffA[0]); PG8_STAGE(PG8_SB(1, 1), cB + kstep, voffB[1]);
    PG8_WAIT_V(6); PG8_BAR;
    bool chain_mid = false;
    for (;;) {
        const bool has_next = S.next(ui + 1, nxt);
        const char* nA = has_next ? S.a_base(nxt) : cA; const char* nB = has_next ? S.b_base(nxt) : cB;
        if (GATHER) {
            if (has_next) S.a_offsets(nxt, Rl, Cl, voffAn);
            else {
#pragma unroll
                for (int h = 0; h < 2; ++h)
#pragma unroll
                    for (int i = 0; i < 2; ++i) voffAn[h][i] = voffA[h][i];
            }
        }
#pragma unroll 1
        for (int t = 0; t < nt; t += 2) {
            const bool last = (t == nt - 2);
            const char* a1 = cA + (size_t)(t + 1) * kstep;
            const char* a2 = last ? nA : cA + (size_t)(t + 2) * kstep; const char* b2 = last ? nB : cB + (size_t)(t + 2) * kstep;
            const char* a3 = a2 + kstep; const char* b3 = b2 + kstep;
            unsigned o2[2][2];
#pragma unroll
            for (int h = 0; h < 2; ++h)
#pragma unroll
                for (int i = 0; i < 2; ++i) o2[h][i] = (GATHER && last) ? voffAn[h][i] : voffA[h][i];
            PG8_LDB(B0, 0, 0); PG8_LDB(B1, 0, 1); PG8_SCHED; PG8_LDA(At, 0, 0); PG8_STAGE(PG8_SA(1, 1), a1, voffA[1]);
            PG8_WAIT_V(8); PG8_WAIT_L(0); PG8_BAR; PG8_MMA(0, 0, At, B0); PG8_MMA(0, 1, At, B1); PG8_BAR; PG8_SCHED;
            PG8_LDA(At, 0, 1); PG8_STAGE(PG8_SB(0, 0), b2, voffB[0]); PG8_STAGE(PG8_SB(0, 1), b2, voffB[1]); PG8_STAGE(PG8_SA(0, 0), a2, o2[0]);
            PG8_WAIT_V(8); PG8_WAIT_L(0); PG8_BAR; PG8_MMA(1, 0, At, B0); PG8_MMA(1, 1, At, B1); PG8_BAR; PG8_SCHED;
            PG8_LDB(B0, 1, 0); PG8_LDB(B1, 1, 1); PG8_SCHED; PG8_LDA(At, 1, 0); PG8_STAGE(PG8_SA(0, 1), a2, o2[1]);
            PG8_WAIT_V(8); PG8_WAIT_L(0); PG8_BAR; PG8_MMA(0, 0, At, B0); PG8_MMA(0, 1, At, B1); PG8_BAR; PG8_SCHED;
            PG8_LDA(At, 1, 1); PG8_STAGE(PG8_SB(1, 0), b3, voffB[0]); PG8_STAGE(PG8_SB(1, 1), b3, voffB[1]); PG8_STAGE(PG8_SA(1, 0), a3, o2[0]);
            PG8_WAIT_V(8); PG8_WAIT_L(0); PG8_BAR; PG8_MMA(1, 0, At, B0); PG8_MMA(1, 1, At, B1); PG8_BAR; PG8_SCHED;
        }
        if (wr == 0) PG8_BAR;
        if (F8) asm volatile("s_nop 15\n\ts_nop 15" ::: "memory");
        { Unit ecur; ecur.pm = __builtin_amdgcn_readfirstlane(cur.pm); ecur.pn = __builtin_amdgcn_readfirstlane(cur.pn); ecur.e = __builtin_amdgcn_readfirstlane(cur.e); ecur.r0 = __builtin_amdgcn_readfirstlane(cur.r0);
          asm volatile("" : "+s"(ecur.pm), "+s"(ecur.pn), "+s"(ecur.e), "+s"(ecur.r0));
          int efr = fr, efq = fq; asm volatile("" : "+v"(efr), "+v"(efq));
          f32x4 acc[2][2][4][2];
#pragma unroll
          for (int a = 0; a < 2; ++a)
#pragma unroll
              for (int b = 0; b < 2; ++b)
#pragma unroll
                  for (int m = 0; m < 4; ++m) { acc[a][b][m][0] = acc8[a][b][m].lo; acc[a][b][m][1] = acc8[a][b][m].hi; }
          if constexpr (EpiChain<Epi>::value) {
              chain_mid = S.is_mid(ecur);
              if (chain_mid) { E.mid(acc, ecur, wr, wc, efr, efq);
#pragma unroll
                  for (int a = 0; a < 2; ++a)
#pragma unroll
                      for (int b = 0; b < 2; ++b)
#pragma unroll
                          for (int m = 0; m < 4; ++m) { acc8[a][b][m].lo = acc[a][b][m][0]; acc8[a][b][m].hi = acc[a][b][m][1]; } }
              else E(acc, ecur, wr, wc, efr, efq);
          } else E(acc, ecur, wr, wc, efr, efq); }
        if (!has_next) break;
        if (!chain_mid) {
#pragma unroll
        for (int a = 0; a < 2; ++a)
#pragma unroll
            for (int b = 0; b < 2; ++b)
#pragma unroll
                for (int m = 0; m < 4; ++m) acc8[a][b][m] = (f32x8v){0.f, 0.f, 0.f, 0.f, 0.f, 0.f, 0.f, 0.f};
        }
        cur = nxt; cA = nA; cB = nB; ++ui;
        if (GATHER) {
#pragma unroll
            for (int h = 0; h < 2; ++h)
#pragma unroll
                for (int i = 0; i < 2; ++i) voffA[h][i] = voffAn[h][i];
        }
        if (wr == 1) PG8_BAR;
    }
    PG8_WAIT_V(0);
    PG8_BAR;
#undef PG8_SA
#undef PG8_SB
#undef PG8_STAGE
#undef PG8_LDA
#undef PG8_LDB
#undef PG8_MMA
#undef PG8_WAIT_V
#undef PG8_WAIT_L
#undef PG8_BAR
#undef PG8_SCHED
}
}

DEVINL int opaque_tid() { int t = threadIdx.x; asm volatile("" : "+v"(t)); return t; }
DEVINL unsigned pk4_fp8(float a, float b, float c, float d) { int w = __builtin_amdgcn_cvt_pk_fp8_f32(a, b, 0, false); w = __builtin_amdgcn_cvt_pk_fp8_f32(c, d, w, true); return (unsigned)w; }
DEVINL float fsig(float v) { return __builtin_amdgcn_rcpf(1.0f + __expf(-v)); }
using pg8::Unit; using pg8::u32x4; using pg8::cvt_pk_bf16;

template <int MODE> DEVINL float act_mode(float v) { if (MODE == 0) return v * fsig(v); if (MODE == 3) return fsig(v); if (MODE == 4) return v * 0.18033688011112042f; return v; }
template <int MODE> DEVINL void store_bf16_tile(const f32x4 (&acc)[2][2][4][2], bf16_t* base, int pitch, int row0, int col0, float sc) {
#pragma unroll
    for (int ai = 0; ai < 2; ++ai)
#pragma unroll
        for (int m = 0; m < 4; ++m) { bf16_t* rowp = base + (size_t)(row0 + ai * 128 + m * 16) * pitch + col0;
#pragma unroll
            for (int bj = 0; bj < 2; ++bj) { const f32x4 v0 = acc[ai][bj][m][0] * sc, v1 = acc[ai][bj][m][1] * sc; u32x4 w;
                w.x = cvt_pk_bf16(act_mode<MODE>(v0[0]), act_mode<MODE>(v0[1])); w.y = cvt_pk_bf16(act_mode<MODE>(v0[2]), act_mode<MODE>(v0[3]));
                w.z = cvt_pk_bf16(act_mode<MODE>(v1[0]), act_mode<MODE>(v1[1])); w.w = cvt_pk_bf16(act_mode<MODE>(v1[2]), act_mode<MODE>(v1[3]));
                *(u32x4*)(rowp + bj * 32) = w; } }
}
template <bool F8> struct EpiInproj {
    static constexpr bool PERM = true; static constexpr int NVM = 0;
    unsigned char* ws; const float* lb;
    DEVINL void operator()(const f32x4 (&acc)[2][2][4][2], const Unit& u, int wr, int wc, int fr, int fq) const {
        const int sidx = u.pn >> 1; const int seg = F8 ? (sidx == 0 ? 3 : 6 + sidx) : (sidx < 3 ? sidx : sidx + 1);
        const int row0 = u.pm * 256 + wr * 64 + fr; const int cseg = (u.pn & 1) * 256 + wc * 64 + 8 * fq;
        const float sc = F8 ? (1.0f / 32.0f) : 1.0f;
        if (!F8 && seg == 1) {
            _Float16* base = (_Float16*)(ws + OFF_LF);
            f32x4 lbv[2][2];
#pragma unroll
            for (int bj = 0; bj < 2; ++bj)
#pragma unroll
                for (int n = 0; n < 2; ++n) lbv[bj][n] = *(const f32x4*)(lb + cseg + 32 * bj + 4 * n);
#pragma unroll
            for (int ai = 0; ai < 2; ++ai)
#pragma unroll
                for (int m = 0; m < 4; ++m) { _Float16* rowp = base + (size_t)(row0 + ai * 128 + m * 16) * 512 + cseg;
#pragma unroll
                    for (int bj = 0; bj < 2; ++bj) { typedef _Float16 h8_t __attribute__((ext_vector_type(8))); h8_t o;
#pragma unroll
                        for (int n = 0; n < 2; ++n) { const f32x4 v = acc[ai][bj][m][n]; const f32x4 l = lbv[bj][n];
#pragma unroll
                            for (int j = 0; j < 4; ++j) o[4 * n + j] = (_Float16)__logf(l[j] + (1.0f - l[j]) * fsig(v[j])); }
                        *(h8_t*)(rowp + bj * 32) = o; } }
        } else if (!F8 && seg == 0) store_bf16_tile<0>(acc, (bf16_t*)(ws + OFF_QA), 512, row0, cseg, sc);
        else if (!F8 && seg == 2) store_bf16_tile<2>(acc, (bf16_t*)(ws + OFF_HV), 512, row0, cseg, sc);
        else if (!F8 && seg == 4) store_bf16_tile<4>(acc, (bf16_t*)(ws + OFF_DQ), 512, row0, cseg, sc);
        else if (!F8 && seg == 5) { store_bf16_tile<2>(acc, (bf16_t*)(ws + OFF_DK), 512, row0, cseg, sc);
            float mx = 0.f;
#pragma unroll
            for (int ai = 0; ai < 2; ++ai)
#pragma unroll
                for (int m = 0; m < 4; ++m) { float q2 = 0.f;
#pragma unroll
                    for (int bj = 0; bj < 2; ++bj)
#pragma unroll
                        for (int n = 0; n < 2; ++n) { const f32x4 v = acc[ai][bj][m][n]; const unsigned w0 = cvt_pk_bf16(v[0], v[1]), w1 = cvt_pk_bf16(v[2], v[3]);
                            const float a0 = __uint_as_float(w0 << 16), a1 = __uint_as_float(w0 & 0xffff0000u), a2 = __uint_as_float(w1 << 16), a3 = __uint_as_float(w1 & 0xffff0000u);
                            q2 += (a0 * a0 + a1 * a1) + (a2 * a2 + a3 * a3); }
                    q2 += __shfl_xor(q2, 16); q2 += __shfl_xor(q2, 32); mx = fmaxf(mx, q2); }
            mx = fmaxf(mx, __shfl_xor(mx, 1)); mx = fmaxf(mx, __shfl_xor(mx, 2)); mx = fmaxf(mx, __shfl_xor(mx, 4)); mx = fmaxf(mx, __shfl_xor(mx, 8));
            if (fr == 0 && fq == 0) atomicMax((unsigned*)(ws + OFF_SMALL + 4096) + 128 + (u.pm * 256 / SEQ) * 8 + (u.pn & 1) * 4 + wc, __float_as_uint(mx)); }
        else if (!F8 && seg == 6) store_bf16_tile<2>(acc, (bf16_t*)(ws + OFF_DV), 512, row0, cseg, sc);
        else if (F8 && seg == 3) store_bf16_tile<3>(acc, (bf16_t*)(ws + OFF_HG), 512, row0, cseg, sc);
        else if (F8) {
            bf16_t* Rp = (bf16_t*)(ws + OFF_GA); bf16_t* Gp = (bf16_t*)(ws + OFF_GB); const int gcol = (u.pn - 2) * 128 + wc * 32 + 8 * fq;
#pragma unroll
            for (int ai = 0; ai < 2; ++ai)
#pragma unroll
                for (int m = 0; m < 4; ++m) { const size_t ro = (size_t)(row0 + ai * 128 + m * 16) * 1024 + gcol; float rr[8], gg[8];
#pragma unroll
                    for (int n = 0; n < 2; ++n)
#pragma unroll
                        for (int e = 0; e < 4; ++e) { const float ea = __expf(-acc[ai][0][m][n][e] * sc), eb = fminf(__expf(-acc[ai][1][m][n][e] * sc), 1e20f);
                            rr[4 * n + e] = (1.0f + eb) * __builtin_amdgcn_rcpf(1.0f + ea); gg[4 * n + e] = __builtin_amdgcn_rcpf(1.0f + eb); }
                    u32x4 wr_, wg_; wr_.x = cvt_pk_bf16(rr[0], rr[1]); wr_.y = cvt_pk_bf16(rr[2], rr[3]); wr_.z = cvt_pk_bf16(rr[4], rr[5]); wr_.w = cvt_pk_bf16(rr[6], rr[7]);
                    wg_.x = cvt_pk_bf16(gg[0], gg[1]); wg_.y = cvt_pk_bf16(gg[2], gg[3]); wg_.z = cvt_pk_bf16(gg[4], gg[5]); wg_.w = cvt_pk_bf16(gg[6], gg[7]);
                    *(u32x4*)(Rp + ro) = wr_; *(u32x4*)(Gp + ro) = wg_; }
        }
    }
};
template <> struct pg8::EpiWide2<EpiInproj<false>> { static constexpr bool value = true; };
template <> struct pg8::EpiWide2<EpiInproj<true>> { static constexpr bool value = true; };
DEVINL f32x4 bf4_lo(const u32x4 w) { return (f32x4){__uint_as_float(w.x << 16), __uint_as_float(w.x & 0xffff0000u), __uint_as_float(w.y << 16), __uint_as_float(w.y & 0xffff0000u)}; }
DEVINL f32x4 bf4_hi(const u32x4 w) { return (f32x4){__uint_as_float(w.z << 16), __uint_as_float(w.z & 0xffff0000u), __uint_as_float(w.w << 16), __uint_as_float(w.w & 0xffff0000u)}; }
struct BranchOrder {
    const char* A0; const char* A1; const char* B0; const char* B1; int nM, nN, G, c;
    DEVINL bool next(int i, Unit& u) const { const long L = (long)(i >> 1) * G + c; if (L >= (long)nM * nN) return false; pg8::order_decode(L, nM, nN, u.pm, u.pn); u.e = i & 1; u.r0 = 0; return true; }
    DEVINL const char* a_base(const Unit& u) const { return (u.e ? A1 : A0) + (size_t)u.pm * (256 * 512 * 2); }
    DEVINL const char* b_base(const Unit& u) const { return (u.e ? B1 : B0) + (size_t)u.pn * (256 * 512 * 2); }
    DEVINL bool is_mid(const Unit& u) const { return u.e == 0; }
    DEVINL void a_offsets(const Unit&, const int (&Rl)[2], const int (&Cl)[2], unsigned (&off)[2][2]) const {
#pragma unroll
        for (int h = 0; h < 2; ++h)
#pragma unroll
            for (int i = 0; i < 2; ++i) off[h][i] = (unsigned)((h * 128 + Rl[i]) * 512 + Cl[i]) * 2u;
    }
};
struct EpiBranchChain {
    static constexpr bool PERM = true;
    const bf16_t* GA; const bf16_t* GB; bf16_t* M;
    DEVINL void mid(f32x4 (&acc)[2][2][4][2], const Unit& u, int wr, int wc, int fr, int fq) const {
        const int row0 = u.pm * 256 + wr * 64 + fr, col0 = u.pn * 256 + wc * 64 + 8 * fq;
#pragma unroll
        for (int ai = 0; ai < 2; ++ai)
#pragma unroll
            for (int m = 0; m < 4; ++m) { const size_t ro = (size_t)(row0 + ai * 128 + m * 16) * 1024 + col0;
#pragma unroll
                for (int bj = 0; bj < 2; ++bj) { const u32x4 ga = *(const u32x4*)(GA + ro + bj * 32);
                    const f32x4 a0 = bf4_lo(ga), a1 = bf4_hi(ga);
#pragma unroll
                    for (int e = 0; e < 4; ++e) { acc[ai][bj][m][0][e] *= a0[e]; acc[ai][bj][m][1][e] *= a1[e]; } } }
    }
    DEVINL void operator()(const f32x4 (&acc)[2][2][4][2], const Unit& u, int wr, int wc, int fr, int fq) const {
        const int row0 = u.pm * 256 + wr * 64 + fr, col0 = u.pn * 256 + wc * 64 + 8 * fq;
#pragma unroll
        for (int ai = 0; ai < 2; ++ai)
#pragma unroll
            for (int m = 0; m < 4; ++m) { const size_t ro = (size_t)(row0 + ai * 128 + m * 16) * 1024 + col0;
#pragma unroll
                for (int bj = 0; bj < 2; ++bj) { const u32x4 gb = *(const u32x4*)(GB + ro + bj * 32); const f32x4 v0 = acc[ai][bj][m][0] * bf4_lo(gb), v1 = acc[ai][bj][m][1] * bf4_hi(gb);
                    u32x4 w; w.x = cvt_pk_bf16(v0[0], v0[1]); w.y = cvt_pk_bf16(v0[2], v0[3]); w.z = cvt_pk_bf16(v1[0], v1[1]); w.w = cvt_pk_bf16(v1[2], v1[3]);
                    *(u32x4*)(M + ro + bj * 32) = w; } }
    }
};
template <> struct pg8::EpiWide2<EpiBranchChain> { static constexpr bool value = true; };
template <> struct pg8::EpiChain<EpiBranchChain> { static constexpr bool value = true; };
struct EpiOutLn {
    static constexpr bool PERM = true;
    const bf16_t* x; const float* g; const float* bta; bf16_t* H1; unsigned char* H1B;
    unsigned long long* xbuf; unsigned* cnt; unsigned* tmo; PG8_LAS unsigned char* tab;
    DEVINL void operator()(f32x4 (&acc)[2][2][4][2], const Unit& u, int wr, int wc, int fr, int fq) const {
        typedef float f2_t __attribute__((ext_vector_type(2)));
        const int row0 = u.pm * 256 + wr * 64 + fr, col0 = u.pn * 256 + wc * 64 + 8 * fq; const int wid = wr * 4 + wc, lane = fq * 16 + fr;
        PG8_LAS f2_t* P = (PG8_LAS f2_t*)tab; PG8_LAS f2_t* S = (PG8_LAS f2_t*)(tab + 8192); PG8_LAS unsigned* flag = (PG8_LAS unsigned*)(tab + 8192 + 2048);
#pragma unroll
        for (int ai = 0; ai < 2; ++ai)
#pragma unroll
            for (int m = 0; m < 4; ++m) { int c0 = col0; if (m & 1) asm volatile("" : "+v"(c0)); else asm volatile("" : "+v"(c0) :: "memory");
                const size_t ro = (size_t)(row0 + ai * 128 + m * 16) * 1024 + c0;
#pragma unroll
                for (int bj = 0; bj < 2; ++bj) { const u32x4 xw = *(const u32x4*)(x + ro + bj * 32); const f32x4 x0 = bf4_lo(xw), x1 = bf4_hi(xw);
                    acc[ai][bj][m][0] = x0 * DN_ALPHA + acc[ai][bj][m][0]; acc[ai][bj][m][1] = x1 * DN_ALPHA + acc[ai][bj][m][1]; }
                float s_ = 0.f;
#pragma unroll
                for (int bj = 0; bj < 2; ++bj)
#pragma unroll
                    for (int n = 0; n < 2; ++n) { const f32x4 v = acc[ai][bj][m][n]; s_ += (v[0] + v[1]) + (v[2] + v[3]); }
                s_ += __shfl_xor(s_, 16); s_ += __shfl_xor(s_, 32);
                const float mw = s_ * (1.0f / 64.0f); float q = 0.f;
#pragma unroll
                for (int bj = 0; bj < 2; ++bj)
#pragma unroll
                    for (int n = 0; n < 2; ++n) { const f32x4 d = acc[ai][bj][m][n] - mw; q += (d[0] * d[0] + d[1] * d[1]) + (d[2] * d[2] + d[3] * d[3]); }
                q += __shfl_xor(q, 16); q += __shfl_xor(q, 32);
                if (fq == 0) P[(ai * 128 + wr * 64 + m * 16 + fr) * 4 + wc] = (f2_t){mw, q}; }
        asm volatile("s_waitcnt lgkmcnt(0)" ::: "memory"); __builtin_amdgcn_s_barrier(); asm volatile("" ::: "memory");
        __builtin_amdgcn_sched_barrier(0);
        const int row = wid * 32 + (lane & 31);
        if (lane < 32) { const f2_t a = P[row * 4 + 0], b = P[row * 4 + 1], c = P[row * 4 + 2], d = P[row * 4 + 3];
            const float mt = (a.x + b.x + c.x + d.x) * 0.25f; const float da = a.x - mt, db = b.x - mt, dc = c.x - mt, dd = d.x - mt;
            const float m2 = (a.y + b.y) + (c.y + d.y) + 64.0f * ((da * da + db * db) + (dc * dc + dd * dd));
            __hip_atomic_store(xbuf + ((size_t)(u.pm * 256 + row) * 4 + u.pn), ((unsigned long long)__float_as_uint(m2) << 32) | __float_as_uint(mt), __ATOMIC_RELAXED, __HIP_MEMORY_SCOPE_AGENT); }
        asm volatile("s_waitcnt vmcnt(0)" ::: "memory");
        if (lane == 0) __hip_atomic_fetch_add(cnt + 64 * u.pm, 1u, __ATOMIC_RELAXED, __HIP_MEMORY_SCOPE_AGENT);
        if (wid == 0) { bool dead = false; unsigned sp = 0u;
            for (;;) { if ((unsigned)__builtin_amdgcn_readfirstlane(__hip_atomic_load(cnt + 64 * u.pm, __ATOMIC_RELAXED, __HIP_MEMORY_SCOPE_AGENT)) >= 32u) break;
                if (++sp > (1u << 18)) { if (lane == 0) __hip_atomic_store(tmo, 1u, __ATOMIC_RELAXED, __HIP_MEMORY_SCOPE_AGENT); dead = true; break; }
                __builtin_amdgcn_s_sleep(2); }
            __builtin_amdgcn_fence(__ATOMIC_ACQUIRE, "agent");
            if (lane == 0) flag[0] = dead ? 1u : 0u; }
        asm volatile("s_waitcnt vmcnt(0) lgkmcnt(0)" ::: "memory"); __builtin_amdgcn_s_barrier(); asm volatile("" ::: "memory");
        const bool bad = flag[0] != 0u;
        if (lane < 32) { const unsigned long long* slot = xbuf + (size_t)(u.pm * 256 + row) * 4; float mt[4], m2[4]; float ms = 0.f;
#pragma unroll
            for (int t = 0; t < 4; ++t) { const unsigned long long w = __hip_atomic_load(slot + t, __ATOMIC_RELAXED, __HIP_MEMORY_SCOPE_AGENT); mt[t] = __uint_as_float((unsigned)w); m2[t] = __uint_as_float((unsigned)(w >> 32)); ms += mt[t]; }
            const float mean = ms * 0.25f; float q = 0.f;
#pragma unroll
            for (int t = 0; t < 4; ++t) { const float dm = mt[t] - mean; q += m2[t] + 256.0f * dm * dm; }
            S[row] = (f2_t){mean, rsqrtf(q * (1.0f / 1024.0f) + 1e-5f)}; }
        asm volatile("s_waitcnt lgkmcnt(0)" ::: "memory"); __builtin_amdgcn_s_barrier(); asm volatile("" ::: "memory");
        __builtin_amdgcn_sched_barrier(0);
        const float qnan = __builtin_nanf("");
#pragma unroll
        for (int ai = 0; ai < 2; ++ai)
#pragma unroll
            for (int m = 0; m < 4; ++m) { int c0 = col0; asm volatile("" : "+v"(c0));
                int rb_ = row0; asm volatile("" : "+v"(rb_)); const int r = ai * 128 + wr * 64 + m * 16 + fr; const f2_t sr = S[r]; const size_t ro = (size_t)(rb_ + ai * 128 + m * 16) * 1024 + c0;
#pragma unroll
                for (int bj = 0; bj < 2; ++bj) { const PG8_LAS float* gl = (const PG8_LAS float*)(tab + 10368);
                    const f32x4 g0 = *(const PG8_LAS f32x4*)(gl + c0 + bj * 32), g1 = *(const PG8_LAS f32x4*)(gl + c0 + bj * 32 + 4), b0 = *(const PG8_LAS f32x4*)(gl + 1024 + c0 + bj * 32), b1 = *(const PG8_LAS f32x4*)(gl + 1024 + c0 + bj * 32 + 4);
                    f32x4 h0 = (acc[ai][bj][m][0] - sr.x) * sr.y * g0 + b0, h1 = (acc[ai][bj][m][1] - sr.x) * sr.y * g1 + b1;
                    if (bad) { h0 = (f32x4){qnan, qnan, qnan, qnan}; h1 = h0; }
                    u32x4 w; w.x = cvt_pk_bf16(h0[0], h0[1]); w.y = cvt_pk_bf16(h0[2], h0[3]); w.z = cvt_pk_bf16(h1[0], h1[1]); w.w = cvt_pk_bf16(h1[2], h1[3]);
                    *(u32x4*)(H1 + ro + bj * 32) = w;
                    pg8::u32x2 w8; w8.x = pk4_fp8(h0[0], h0[1], h0[2], h0[3]); w8.y = pk4_fp8(h1[0], h1[1], h1[2], h1[3]);
                    *(pg8::u32x2*)(H1B + ro + bj * 32) = w8; }
                asm volatile("" ::: "memory"); }
    }
};
template <> struct pg8::EpiWide2<EpiOutLn> { static constexpr bool value = true; };
#ifndef MOE_WGM
#define MOE_WGM 4
#endif
template <int K, bool GU> struct MoeOrder {
    const PG8_LAS int* tab; int nT, nN, G, c;
    const char* Abase; const char* Bbase; const int* counts; const int* ltok; const PG8_LAS unsigned short* tokl;
    DEVINL bool next(int i, Unit& u) const { const long L = (long)i * G + c; if (L >= (long)nT * nN) return false; int tile, pn; pg8::order_decode<MOE_WGM>(L, nT, nN, tile, pn);
        const int packed = __builtin_amdgcn_readfirstlane(tab[tile]); u.pm = tile; u.pn = pn; u.e = packed & 255; u.r0 = (packed >> 8) * 256; u.ui = i; return true; }
    DEVINL const char* a_base(const Unit& u) const { return GU ? Abase : Abase + (size_t)u.pm * (256 * K * 2); }
    DEVINL const char* b_base(const Unit& u) const { return Bbase + (size_t)u.e * ((GU ? 2048 : 1024) * K * 2) + (size_t)u.pn * (256 * K * 2); }
    DEVINL void a_offsets(const Unit& u, const int (&Rl)[2], const int (&Cl)[2], unsigned (&off)[2][2]) const {
        if (GU) { const PG8_LAS unsigned short* tl = tokl + u.ui * 256;
#pragma unroll
            for (int h = 0; h < 2; ++h)
#pragma unroll
                for (int i = 0; i < 2; ++i) { const int tok = tl[h * 128 + Rl[i]]; off[h][i] = (unsigned)(tok * K + Cl[i]) * 2u; }
        } else {
#pragma unroll
            for (int h = 0; h < 2; ++h)
#pragma unroll
                for (int i = 0; i < 2; ++i) off[h][i] = (unsigned)((h * 128 + Rl[i]) * K + Cl[i]) * 2u;
        }
    }
};
constexpr float F8_WSCALE = 32.0f;
struct EpiGU8 {
    static constexpr bool PERM = true;
    const float* bgu; unsigned char* ACT;
    DEVINL void operator()(const f32x4 (&acc)[2][2][4][2], const Unit& u, int wr, int wc, int fr, int fq) const {
        const int row0 = u.pm * 256 + wr * 64 + fr, ic0 = u.pn * 128 + wc * 32 + 8 * fq;
        const f32x4* bp = (const f32x4*)(bgu + (size_t)u.e * 2048 + 2 * ic0);
        const f32x4 b0 = bp[0], b1 = bp[1], b2 = bp[2], b3 = bp[3];
        typedef float f2_t __attribute__((ext_vector_type(2)));
        const f2_t bg2[4] = {(f2_t){b0[0], b0[2]}, (f2_t){b1[0], b1[2]}, (f2_t){b2[0], b2[2]}, (f2_t){b3[0], b3[2]}}, bu2[4] = {(f2_t){b0[1], b0[3]}, (f2_t){b1[1], b1[3]}, (f2_t){b2[1], b2[3]}, (f2_t){b3[1], b3[3]}};
        const f2_t sc2 = {1.0f / F8_WSCALE, 1.0f / F8_WSCALE}, kk2 = {-1.702f * 1.4426950408889634f, -1.702f * 1.4426950408889634f}, one2 = {1.0f, 1.0f};
#pragma unroll
        for (int ai = 0; ai < 2; ++ai)
#pragma unroll
            for (int m = 0; m < 4; ++m) { unsigned char* rowp = ACT + (size_t)(row0 + ai * 128 + m * 16) * DFF + ic0; float o[8];
#pragma unroll
                for (int p = 0; p < 4; ++p) { const f32x4 ga = acc[ai][0][m][p >> 1], ua = acc[ai][1][m][p >> 1];
                    f2_t gate = (f2_t){ga[2 * (p & 1)], ga[2 * (p & 1) + 1]} * sc2 + bg2[p], up = (f2_t){ua[2 * (p & 1)], ua[2 * (p & 1) + 1]} * sc2 + bu2[p];
                    gate.x = fminf(gate.x, 7.0f); gate.y = fminf(gate.y, 7.0f); up.x = fminf(fmaxf(up.x, -7.0f), 7.0f); up.y = fminf(fmaxf(up.y, -7.0f), 7.0f);
                    const f2_t t = gate * kk2; f2_t e; e.x = __builtin_amdgcn_exp2f(t.x); e.y = __builtin_amdgcn_exp2f(t.y);
                    const f2_t d = e + one2; f2_t r; r.x = __builtin_amdgcn_rcpf(d.x); r.y = __builtin_amdgcn_rcpf(d.y);
                    const f2_t glu = gate * r, ov = up * glu + glu; o[2 * p] = ov.x; o[2 * p + 1] = ov.y; }
                pg8::u32x2 w; w.x = pk4_fp8(o[0], o[1], o[2], o[3]); w.y = pk4_fp8(o[4], o[5], o[6], o[7]);
                *(pg8::u32x2*)rowp = w; }
    }
};
constexpr float Y2_SCALE = 8.0f;
struct EpiDown8 {
    static constexpr bool PERM = true;
    const float* bd; unsigned char* Y2;
    DEVINL void operator()(const f32x4 (&acc)[2][2][4][2], const Unit& u, int wr, int wc, int fr, int fq) const {
        const int rl0 = wr * 64 + fr, col0 = u.pn * 256 + wc * 64 + 16 * fq;
        f32x4 bv[2][2];
#pragma unroll
        for (int bj = 0; bj < 2; ++bj)
#pragma unroll
            for (int n = 0; n < 2; ++n) bv[bj][n] = *(const f32x4*)(bd + (size_t)u.e * DM + col0 + 8 * bj + 4 * n) * Y2_SCALE;
#pragma unroll
        for (int ai = 0; ai < 2; ++ai)
#pragma unroll
            for (int m = 0; m < 4; ++m) { const int rl = rl0 + ai * 128 + m * 16; u32x4 w;
                { const f32x4 v = acc[ai][0][m][0] * (Y2_SCALE / F8_WSCALE) + bv[0][0]; w.x = pk4_fp8(v[0], v[1], v[2], v[3]); }
                { const f32x4 v = acc[ai][0][m][1] * (Y2_SCALE / F8_WSCALE) + bv[0][1]; w.y = pk4_fp8(v[0], v[1], v[2], v[3]); }
                { const f32x4 v = acc[ai][1][m][0] * (Y2_SCALE / F8_WSCALE) + bv[1][0]; w.z = pk4_fp8(v[0], v[1], v[2], v[3]); }
                { const f32x4 v = acc[ai][1][m][1] * (Y2_SCALE / F8_WSCALE) + bv[1][1]; w.w = pk4_fp8(v[0], v[1], v[2], v[3]); }
                *(u32x4*)(Y2 + (size_t)(u.pm * 256 + rl) * DM + col0) = w; }
    }
};
template <> struct pg8::EpiWide<EpiDown8> { static constexpr bool value = true; };
#define XB_TMO      128
#define XB_XCNT(j)  (256  + 64 * (j))
#define XB_XSUB(j)  (1280 + 64 * (j))
#define XB_XGEN(j)  (2304 + 64 * (j))
#define XB_TOP      3328
#define XB_TOPGEN   3392
#define XCD_BAR_WORDS 3456
#define XB_SPIN_CAP (1u << 18)
#define LAS __attribute__((address_space(3)))
__device__ __forceinline__ unsigned xb_ld(unsigned* p)              { return __hip_atomic_load(p, __ATOMIC_RELAXED, __HIP_MEMORY_SCOPE_AGENT); }
__device__ __forceinline__ unsigned xb_add(unsigned* p, unsigned v) { return __hip_atomic_fetch_add(p, v, __ATOMIC_RELAXED, __HIP_MEMORY_SCOPE_AGENT); }
__device__ __forceinline__ unsigned xb_xcc_id() { return (unsigned)__builtin_amdgcn_s_getreg((3 << 11) | 20) & 0xFu; }
#define XB_SPIN(cond, bar) do { unsigned _sp = 0; while (cond) { __builtin_amdgcn_s_sleep(1); \
    if ((++_sp & 255u) == 0u) { if (xb_ld(&(bar)[XB_TMO])) break; if (_sp > XB_SPIN_CAP) { atomicAdd(&(bar)[XB_TMO], 1u); break; } } } } while (0)
struct XcdBarrier { unsigned* bar; unsigned x; volatile LAS unsigned* st; };
__device__ __forceinline__ XcdBarrier xcd_barrier_post(unsigned* bar, volatile LAS unsigned* st) {
    XcdBarrier b; b.bar = bar; b.x = xb_xcc_id(); b.st = st;
    if (threadIdx.x == 0) (void)xb_add(&bar[XB_XCNT(b.x)], 1u);
    return b;
}
__device__ __forceinline__ void xcd_barrier_complete(unsigned* bar, unsigned x, unsigned& nloc, unsigned& nx) {
    const unsigned G = gridDim.x * gridDim.y * gridDim.z;
    unsigned sum, cnt, mine, sp = 0u;
    for (;;) {
        sum = 0u; cnt = 0u; mine = 0u;
#pragma unroll
        for (unsigned j = 0; j < 16; ++j) { const unsigned c = xb_ld(&bar[XB_XCNT(j)]); sum += c; cnt += (c > 0u) ? 1u : 0u; mine = (j == x) ? c : mine; }
        if (sum == G) break;
        __builtin_amdgcn_s_sleep(1);
        if ((++sp & 255u) == 0u) { if (xb_ld(&bar[XB_TMO])) break; if (sp > XB_SPIN_CAP) { atomicAdd(&bar[XB_TMO], 1u); break; } }
    }
    nloc = mine > 0u ? mine : 1u; nx = cnt > 0u ? cnt : 1u;
}
__device__ __forceinline__ void xcd_barrier(const XcdBarrier& b) {
    asm volatile("s_waitcnt vmcnt(0)" ::: "memory");
    __syncthreads();
    if (threadIdx.x == 0) {
        unsigned* bar = b.bar;
        __builtin_amdgcn_s_waitcnt(0);
        unsigned nloc = b.st[0], nx = b.st[1];
        if (nloc == 0u) { xcd_barrier_complete(bar, b.x, nloc, nx); b.st[0] = nloc; b.st[1] = nx; }
        const unsigned old = xb_add(&bar[XB_XSUB(b.x)], 1u);
        const unsigned gen = old / nloc;
        if (old + 1u == (gen + 1u) * nloc) {
            __builtin_amdgcn_fence(__ATOMIC_RELEASE, "agent");
            asm volatile("s_waitcnt vmcnt(0)" ::: "memory");
            const unsigned og = xb_add(&bar[XB_TOP], 1u);
            const unsigned tg = og / nx;
            if (og + 1u == (tg + 1u) * nx) xb_add(&bar[XB_TOPGEN], 1u);
            else XB_SPIN(xb_ld(&bar[XB_TOPGEN]) == tg, bar);
            __builtin_amdgcn_fence(__ATOMIC_ACQUIRE, "agent");
            asm volatile("s_waitcnt vmcnt(0)" ::: "memory");
        } else {
            XB_SPIN(xb_ld(&bar[XB_TOPGEN]) == gen, bar);
            __builtin_amdgcn_fence(__ATOMIC_ACQUIRE, "agent");
            asm volatile("s_waitcnt vmcnt(0)" ::: "memory");
        }
    }
    __syncthreads();
}

constexpr int RING_BYTES = 131072, LDS_BYTES = 150528;
constexpr int LC_MISC = 0  , LC_PRE = 256  , LC_TAB = 512  ;
constexpr size_t CTL_OFF = OFF_SMALL + 4096, CTL_BYTES = 65536, CTL_BAR = 1024;
enum { PH_PRO = 0, PH_INPROJ = 1, PH_HGA = 2, PH_ATT = 3, PH_BRANCH = 4, PH_OUT = 5, PH_LN1 = 6, PH_GU = 7, PH_DOWN = 8, PH_LN2 = 9, PH_END = 10 };
struct Args { const float* in[19]; float* out; unsigned char* ws; int ph_lo, ph_hi, li, pad; };


constexpr int RING_BYTES_C = 131072, LDSCTL_OFF = 131072;
typedef unsigned v4u_t __attribute__((ext_vector_type(4)));
DEVINL unsigned pk2bf(float lo, float hi) { return (unsigned)f2bf(lo) | ((unsigned)f2bf(hi) << 16); }
template <bool GUPERM> DEVINL void transpose_item(const float* W, int K, int N, bf16_t* WT, int item, int lane, int ld = 0) {
    if (ld == 0) ld = N;
    const int nblk = N / 64, kb = item / nblk, nb = item % nblk, k0 = 64 * kb + 16 * (lane >> 4), n0 = 64 * nb + 4 * (lane & 15);
    f32x4 v[16];
#pragma unroll
    for (int i = 0; i < 16; ++i) v[i] = *(const f32x4*)(W + (size_t)(k0 + i) * ld + n0);
#pragma unroll
    for (int n = 0; n < 4; ++n) { int nn = n0 + n; if (GUPERM) { const int ii = nn >> 1, g = nn & 1; nn = 256 * (ii >> 7) + 128 * g + (ii & 127); }
        v4u_t o0, o1; o0.x = pk2bf(v[0][n], v[1][n]); o0.y = pk2bf(v[2][n], v[3][n]); o0.z = pk2bf(v[4][n], v[5][n]); o0.w = pk2bf(v[6][n], v[7][n]);
        o1.x = pk2bf(v[8][n], v[9][n]); o1.y = pk2bf(v[10][n], v[11][n]); o1.z = pk2bf(v[12][n], v[13][n]); o1.w = pk2bf(v[14][n], v[15][n]);
        v4u_t* dst = (v4u_t*)(WT + (size_t)nn * K + k0); dst[0] = o0; dst[1] = o1; }
}
template <bool GUPERM> DEVINL void transpose_item_f8(const float* W, int K, int N, unsigned char* WT, int item, int lane, int ld = 0, int gperm = -1) {
    if (ld == 0) ld = N;
    const int nblk = N / 64, kb = item / nblk, nb = item % nblk, k0 = 64 * kb + 16 * (lane >> 4), n0 = 64 * nb + 4 * (lane & 15);
    f32x4 v[16];
#pragma unroll
    for (int i = 0; i < 16; ++i) v[i] = *(const f32x4*)(W + (size_t)(k0 + i) * ld + n0);
    unsigned t[4][4];
#pragma unroll
    for (int kq = 0; kq < 4; ++kq) { unsigned r[4];
#pragma unroll
        for (int m = 0; m < 4; ++m) { const f32x4 q = v[4 * kq + m] * F8_WSCALE; r[m] = pk4_fp8(q[0], q[1], q[2], q[3]); }
        const unsigned x0 = __builtin_amdgcn_perm(r[1], r[0], 0x05010400u), x1 = __builtin_amdgcn_perm(r[1], r[0], 0x07030602u), y0 = __builtin_amdgcn_perm(r[3], r[2], 0x05010400u), y1 = __builtin_amdgcn_perm(r[3], r[2], 0x07030602u);
        t[kq][0] = __builtin_amdgcn_perm(y0, x0, 0x05040100u); t[kq][1] = __builtin_amdgcn_perm(y0, x0, 0x07060302u); t[kq][2] = __builtin_amdgcn_perm(y1, x1, 0x05040100u); t[kq][3] = __builtin_amdgcn_perm(y1, x1, 0x07060302u); }
#pragma unroll
    for (int n = 0; n < 4; ++n) { int nn = n0 + n; if (GUPERM) { const int ii = nn >> 1, g = nn & 1; nn = 256 * (ii >> 7) + 128 * g + (ii & 127); }
        if (gperm >= 0) { const int gc = (gperm >> 1) + nn; nn = 256 * (gc >> 7) + 64 * ((gc & 127) >> 5) + 32 * (gperm & 1) + (gc & 31); }
        *(u32x4*)(WT + (size_t)nn * K + k0) = (u32x4){t[0][n], t[1][n], t[2][n], t[3][n]}; }
}
DEVINL void phase_prologue(const Args& a, unsigned char* ws, LAS unsigned char* lds, int G) {
    const int tid = opaque_tid(), lane = tid & 63, wave = tid >> 6;
    float* smallf = (float*)(ws + OFF_SMALL);
    if (blockIdx.x == 0) {
        const float* lbl = a.in[2]; const float* dl = a.in[4];
        smallf[tid] = 1.0f / (1.0f + expf(lbl[512 + tid] - lbl[tid]));
        if (tid < 64) { float p = dl[tid] * dl[64 + tid], q = dl[128 + tid] * dl[192 + tid]; p = wave_sum(p); q = wave_sum(q); if (tid == 0) smallf[512] = expf(p) - expf(q) + LAMBDA_INIT; }
    }
    { const float4* x4 = (const float4*)a.in[0]; uint4* xb = (uint4*)(ws + OFF_XB); const size_t n8 = (size_t)NTOK * DM / 8;
      for (size_t i = (size_t)blockIdx.x * 512 + tid; i < n8; i += (size_t)G * 512) { const float4 p = x4[2 * i], q = x4[2 * i + 1];
          uint4 o; o.x = pk2bf(p.x, p.y); o.y = pk2bf(p.z, p.w); o.z = pk2bf(q.x, q.y); o.w = pk2bf(q.z, q.w); xb[i] = o;
          uint2 o8; o8.x = pk4_fp8(p.x, p.y, p.z, p.w); o8.y = pk4_fp8(q.x, q.y, q.z, q.w); ((uint2*)(ws + OFF_XB8))[i] = o8; } }
    const int gw = blockIdx.x * 8 + wave, NGW = G * 8;
    constexpr int I_IN = (DM / 64) * (DIN / 32), I_A = (512 / 64) * (DM / 64), I_O = (DM / 64) * (DM / 64);
    constexpr int NIT = I_IN + 2 * I_A + I_O;
    for (int it = gw; it < NIT; it += NGW) {
        int r = it;
        if (r < I_IN) {
            const int kb = r / (DIN / 32), nb = r % (DIN / 32), seg = nb >> 4;
            const bool g8 = (seg == 3) || (seg >= 7); const int dseg = g8 ? (seg == 3 ? 0 : seg - 6) : (seg < 3 ? seg : seg - 1);
            if (g8) { if (!(nb & 1)) { if (seg == 3) transpose_item_f8<false>(a.in[1] + seg * 512, DM, 512, (unsigned char*)(ws + OFF_WIN8), kb * 8 + ((nb & 15) >> 1), lane, DIN);
                    else transpose_item_f8<false>(a.in[1] + seg * 512, DM, 512, (unsigned char*)(ws + OFF_WIN8) + (size_t)512 * DM, kb * 8 + ((nb & 15) >> 1), lane, DIN, ((((seg - 7) & 1) * 512) << 1) | (seg >= 9 ? 1 : 0)); } }
            else { if (!(nb & 1)) transpose_item<false>(a.in[1] + seg * 512, DM, 512, (bf16_t*)(ws + OFF_WIN) + (size_t)dseg * 512 * DM, kb * 8 + ((nb & 15) >> 1), lane, DIN); }
            continue; } r -= I_IN;
        if (r < I_A) { transpose_item<false>(a.in[6], 512, DM, (bf16_t*)(ws + OFF_WA), r, lane); continue; } r -= I_A;
        if (r < I_A) { transpose_item<false>(a.in[7], 512, DM, (bf16_t*)(ws + OFF_WB), r, lane); continue; } r -= I_A;
        transpose_item<false>(a.in[8], DM, DM, (bf16_t*)(ws + OFF_WOUT), r, lane);
    }
}
typedef float f32x16 __attribute__((ext_vector_type(16)));
typedef short s16x4_t __attribute__((ext_vector_type(4)));
constexpr size_t CTLX_OFF = OFF_SMALL + 4096;
__device__ const unsigned char ATT_ORDER[64] = {63, 62, 61, 60, 59, 58, 47, 46, 45, 44, 43, 42, 57, 41, 56, 40, 55, 39, 54, 38, 53, 37, 52, 36, 51, 35, 31, 30, 29, 28, 27, 26, 25, 24, 23, 22, 21, 20, 19, 50, 34, 18, 49, 33, 17, 15, 14, 13, 12, 11, 10, 9, 8, 7, 6, 5, 4, 3, 2, 1, 48, 32, 16, 0};
DEVINL int crow(int r, int hi) { return (r & 3) + 8 * (r >> 2) + 4 * hi; }
DEVINL s16x4_t lds_tr16(LAS const unsigned char* p) { return __builtin_bit_cast(s16x4_t, __builtin_amdgcn_ds_read_tr16_b64_v4i16((LAS s16x4_t*)p)); }
constexpr int AT_PK = 144, AT_PV = 320, AT_KBUF = 64 * AT_PK, AT_VBUF = 64 * AT_PV, AT_BUF = AT_KBUF + AT_VBUF, AT_SCR = 2 * AT_BUF, AT_O0 = AT_SCR + 1024;
constexpr float AT_THR = 8.0f;
DEVINL void attn_unit(int b, int h, int qb, int j, const bf16_t* DQ, const bf16_t* DK, const bf16_t* DV, bf16_t* OB, unsigned* O0G, unsigned* ctlx, const float* NG, float lam, LAS unsigned char* lds) {
    int tid_ = threadIdx.x; asm volatile("" : "+v"(tid_));
    const int tid = tid_, lane = tid & 63, wid = __builtin_amdgcn_readfirstlane(tid >> 6), r32 = lane & 31, hi = lane >> 5;
    const int q0 = qb * 256, qw0 = q0 + wid * 32, qpos = qw0 + r32;
    const size_t rowb = (size_t)b * SEQ;
    const float c = exp2f(-2.0f * (float)(h + 1)) * 1.4426950408889634f;
    bf16x8 qf[4];
#pragma unroll
    for (int d0 = 0; d0 < 4; ++d0) qf[d0] = *(const bf16x8*)(DQ + (rowb + qpos) * 512 + h * 128 + j * 64 + d0 * 16 + hi * 8);
    float qkb;
    { float q2 = 0.f;
#pragma unroll
      for (int d0 = 0; d0 < 4; ++d0)
#pragma unroll
          for (int e = 0; e < 8; ++e) { const float v = bf2f((bf16_t)qf[d0][e]); q2 += v * v; }
      q2 += __shfl_xor(q2, 32);
      qkb = sqrtf(q2) * sqrtf(__uint_as_float(ctlx[128 + b * 8 + h * 2 + j])) * 1.001f; }
    f32x16 cr;
#pragma unroll
    for (int r = 0; r < 16; ++r) cr[r] = c * (float)crow(r, hi);
    f32x16 o[4];
#pragma unroll
    for (int d = 0; d < 4; ++d)
#pragma unroll
        for (int r = 0; r < 16; ++r) o[d][r] = 0.f;
    const float at_skip = 28.0f - log2f(1.0f - exp2f(-c));
    float mref = -1e30f, lsum = 0.f, mtrue = -1e30f;
    const int nt = 4 * (qb + 1), sw = 7 - wid;
    const int kkv = tid >> 3, kch = tid & 7, vkv = tid >> 4, vch = tid & 15;
    const bf16_t* kg = DK + (rowb + kkv) * 512 + h * 128 + j * 64 + kch * 8;
    const bf16_t* vg = DV + (rowb + vkv) * 512 + h * 128 + vch * 8;
    const int kdst = kkv * AT_PK + kch * 16, vdst = AT_KBUF + vkv * AT_PV + vch * 16;
    const int kread = r32 * AT_PK + hi * 16;
    const int vread = AT_KBUF + (4 * hi + ((lane & 15) >> 2)) * AT_PV + ((lane >> 4) & 1) * 32 + (lane & 3) * 8;
    LAS float* scr = (LAS float*)(lds + AT_SCR) + wid * 32;
    LAS unsigned* votes = (LAS unsigned*)(lds + LDSCTL_OFF + 320);
    u32x4 kr = *(const u32x4*)(kg + (size_t)(nt - 1) * 64 * 512), vr0, vr1;
    __syncthreads();
    *(LAS u32x4*)(lds + kdst) = kr; *(LAS u32x4*)(lds + AT_BUF + vdst) = kr;
    kr = *(const u32x4*)(kg + (size_t)(nt - 2) * 64 * 512); vr0 = *(const u32x4*)(vg + (size_t)(nt - 1) * 64 * 512); vr1 = *(const u32x4*)(vg + ((size_t)(nt - 1) * 64 + 32) * 512);
    __syncthreads();
    f32x16 pA = cr, pB = cr; u32x4 paw[2] = {(u32x4){0u, 0u, 0u, 0u}, (u32x4){0u, 0u, 0u, 0u}};
#define AT_SB() __builtin_amdgcn_sched_barrier(0)
#define AT_PIN(x) asm volatile("" : "+v"(x))
#define AT_MF(a, b, c) __builtin_amdgcn_mfma_f32_32x32x16_bf16(a, b, c, 0, 0, 0)
#define AT_VLD(K_, S2, D) do { l##K_ = lds_tr16(lds + ubv_ + vread + (16 * (S2)) * AT_PV + 64 * (D)); h##K_ = lds_tr16(lds + ubv_ + vread + (16 * (S2) + 8) * AT_PV + 64 * (D)); } while (0)
#define AT_VF(K_) ((bf16x8){l##K_[0], l##K_[1], l##K_[2], l##K_[3], h##K_[0], h##K_[1], h##K_[2], h##K_[3]})
#define AT_KLD(K_, D0) k##K_ = *(LAS const bf16x8*)(lds + ubk_ + kread + (D0) * 32)
#define AT_GB(PC, S2, D, K_, NEXT, R) do { o[D] = AT_MF(__builtin_bit_cast(bf16x8, paw[S2]), AT_VF(K_), o[D]); NEXT; \
        PC[R] = __builtin_amdgcn_exp2f(PC[R] + e_); PC[(R) + 1] = __builtin_amdgcn_exp2f(PC[(R) + 1] + e_); AT_PIN(PC); AT_SB(); } while (0)
#define AT_GA(PC, PN, D0, K_, CIN, NEXT, R, W0, W1, PW) do { PN = AT_MF(k##K_, qf[D0], CIN); NEXT; \
        ps_ += PC[R]; ps_ += PC[(R) + 1]; ps_ += PC[(R) + 2]; ps_ += PC[(R) + 3]; W0 = cvt_pk_bf16(PC[R], PC[(R) + 1]); W1 = cvt_pk_bf16(PC[(R) + 2], PC[(R) + 3]); AT_PIN(PW); AT_PIN(ps_); AT_SB(); } while (0)
#define AT_STEP(PC, PN, S) do { \
        const int ubk_ = ((((S) + 1) >> 1) & 1) * AT_BUF + (1 - (((S) + 1) & 1)) * 32 * AT_PK, ubv_ = ((((S) - 1) >> 1) & 1) * AT_BUF + (1 - (((S) - 1) & 1)) * 32 * AT_PV; \
        s16x4_t l0, h0, l1, h1, l2, h2; bf16x8 k0, k1, k2; \
        AT_SB(); AT_VLD(0, 0, 0); AT_VLD(1, 0, 1); AT_SB(); \
        if ((S) <= sw) { int lim_ = (S) < sw ? -1 : r32; asm volatile("" : "+v"(lim_)); _Pragma("unroll") for (int r = 0; r < 16; ++r) if (crow(r, hi) > lim_) PC[r] = -INFINITY; } \
        const float tb_ = c * (float)(224 - 32 * (S)); \
        float m0_ = fmaxf(fmaxf(PC[0], PC[1]), PC[2]), m1_ = fmaxf(fmaxf(PC[3], PC[4]), PC[5]); \
        m0_ = fmaxf(fmaxf(m0_, PC[6]), PC[7]); m1_ = fmaxf(fmaxf(m1_, PC[8]), PC[9]); m0_ = fmaxf(fmaxf(m0_, PC[10]), PC[11]); m1_ = fmaxf(fmaxf(m1_, PC[12]), PC[13]); m0_ = fmaxf(fmaxf(m0_, PC[14]), PC[15]); \
        float mt_ = fmaxf(m0_, m1_) + tb_; { const auto rr_ = __builtin_amdgcn_permlane32_swap(__float_as_uint(mt_), __float_as_uint(mt_), false, false); mt_ = fmaxf(__uint_as_float(rr_[0]), __uint_as_float(rr_[1])); } \
        mtrue = fmaxf(mtrue, mt_); const bool resc_ = __any(mt_ > mref + AT_THR); \
        if (resc_) { const float mnew_ = fmaxf(mref, mt_); const float alpha_ = __builtin_amdgcn_exp2f(mref - mnew_); lsum *= alpha_; mref = mnew_; if (hi == 0) scr[r32] = alpha_; } \
        const float e_ = tb_ - mref; float ps_ = 0.f; AT_SB(); \
        AT_GB(PC, 0, 0, 0, AT_VLD(2, 0, 2), 0); AT_GB(PC, 0, 1, 1, AT_VLD(0, 0, 3), 2); AT_GB(PC, 0, 2, 2, AT_VLD(1, 1, 0), 4); AT_GB(PC, 0, 3, 0, AT_VLD(2, 1, 1), 6); \
        AT_GB(PC, 1, 0, 1, AT_VLD(0, 1, 2), 8); AT_GB(PC, 1, 1, 2, AT_VLD(1, 1, 3), 10); AT_GB(PC, 1, 2, 0, AT_KLD(0, 0), 12); AT_GB(PC, 1, 3, 1, AT_KLD(1, 1), 14); \
        AT_GA(PC, PN, 0, 0, cr, AT_KLD(2, 2), 0, paw[0].x, paw[0].y, paw[0]); AT_GA(PC, PN, 1, 1, PN, AT_KLD(0, 3), 4, paw[0].z, paw[0].w, paw[0]); \
        AT_GA(PC, PN, 2, 2, PN, (void)0, 8, paw[1].x, paw[1].y, paw[1]); AT_GA(PC, PN, 3, 0, PN, (void)0, 12, paw[1].z, paw[1].w, paw[1]); \
        lsum += ps_; \
        if (resc_) { _Pragma("unroll") for (int r = 0; r < 16; ++r) { const float a_ = scr[crow(r, hi)]; _Pragma("unroll") for (int d = 0; d < 4; ++d) o[d][r] *= a_; } } } while (0)
    __builtin_amdgcn_sched_barrier(0);
    { bf16x8 kf_[4];
#pragma unroll
      for (int d0 = 0; d0 < 4; ++d0) kf_[d0] = *(LAS const bf16x8*)(lds + 32 * AT_PK + kread + d0 * 32);
      pA = __builtin_amdgcn_mfma_f32_32x32x16_bf16(kf_[0], qf[0], cr, 0, 0, 0);
#pragma unroll
      for (int d0 = 1; d0 < 4; ++d0) pA = __builtin_amdgcn_mfma_f32_32x32x16_bf16(kf_[d0], qf[d0], pA, 0, 0, 0); }
    __builtin_amdgcn_sched_barrier(0);
    const int nsteps = 2 * nt; int s_last = nsteps - 1;
    for (int i = 0; i < nt; ++i) {
        if (2 * i + 1 >= sw) AT_STEP(pA, pB, 2 * i);
        if (i + 1 < nt) *(LAS u32x4*)(lds + ((i + 1) & 1) * AT_BUF + kdst) = kr;
        *(LAS u32x4*)(lds + (i & 1) * AT_BUF + vdst) = vr0; *(LAS u32x4*)(lds + (i & 1) * AT_BUF + vdst + 32 * AT_PV) = vr1;
        if (i + 2 < nt) kr = *(const u32x4*)(kg + (size_t)(nt - 3 - i) * 64 * 512);
        if (i + 1 < nt) { vr0 = *(const u32x4*)(vg + (size_t)(nt - 2 - i) * 64 * 512); vr1 = *(const u32x4*)(vg + ((size_t)(nt - 2 - i) * 64 + 32) * 512); }
        { const bool done_ = __all(qkb + c * (float)(255 - 32 * (2 * i + 1)) < mtrue - at_skip);
          if (lane == 0) votes[(i & 1) * 8 + wid] = done_ ? 1u : 0u; }
        __syncthreads();
        { const u32x4 v0_ = *(LAS const u32x4*)(votes + (i & 1) * 8), v1_ = *(LAS const u32x4*)(votes + (i & 1) * 8 + 4);
          if ((v0_.x & v0_.y & v0_.z & v0_.w & v1_.x & v1_.y & v1_.z & v1_.w) != 0u) { s_last = 2 * i; break; } }
        if (2 * i + 2 >= sw) AT_STEP(pB, pA, 2 * i + 1);
    }
    { const int ubv_ = ((s_last >> 1) & 1) * AT_BUF + (1 - (s_last & 1)) * 32 * AT_PV;
#pragma unroll
      for (int s2 = 0; s2 < 2; ++s2) { s16x4_t lo_[4], hh_[4];
#pragma unroll
          for (int d = 0; d < 4; ++d) { lo_[d] = lds_tr16(lds + ubv_ + vread + (16 * s2) * AT_PV + 64 * d); hh_[d] = lds_tr16(lds + ubv_ + vread + (16 * s2 + 8) * AT_PV + 64 * d); }
#pragma unroll
          for (int d = 0; d < 4; ++d) { const bf16x8 vf_ = (bf16x8){lo_[d][0], lo_[d][1], lo_[d][2], lo_[d][3], hh_[d][0], hh_[d][1], hh_[d][2], hh_[d][3]};
              o[d] = __builtin_amdgcn_mfma_f32_32x32x16_bf16(__builtin_bit_cast(bf16x8, paw[s2]), vf_, o[d], 0, 0, 0); } } }
#undef AT_SB
#undef AT_PIN
#undef AT_MF
#undef AT_VLD
#undef AT_VF
#undef AT_KLD
#undef AT_GB
#undef AT_GA
#undef AT_STEP
    lsum += __shfl_xor(lsum, 32);
    asm volatile("" ::: "memory");
    if (hi == 0) scr[r32] = 1.0f / lsum;
    const int item3 = (b * 4 + h) * 16 + qb;
    unsigned* o0s = O0G + ((size_t)item3 * 8 + wid) * 2048 + lane;
    unsigned* flag = ctlx + 4096 + item3;
    if (j == 0) {
#pragma unroll
        for (int r = 0; r < 16; ++r) { const float il = scr[crow(r, hi)];
#pragma unroll
            for (int d = 0; d < 4; d += 2) __hip_atomic_store(o0s + ((d >> 1) * 16 + r) * 64, cvt_pk_bf16(o[d][r] * il, o[d + 1][r] * il), __ATOMIC_RELAXED, __HIP_MEMORY_SCOPE_AGENT); }
        asm volatile("s_waitcnt vmcnt(0)" ::: "memory");
        __syncthreads();
        if (tid == 0) __hip_atomic_store(flag, 1u, __ATOMIC_RELAXED, __HIP_MEMORY_SCOPE_AGENT);
    } else {
        if (tid == 0) { unsigned sp = 0; while (__hip_atomic_load(flag, __ATOMIC_RELAXED, __HIP_MEMORY_SCOPE_AGENT) == 0u) { __builtin_amdgcn_s_sleep(8); if (++sp > (1u << 22)) break; } }
        __syncthreads();
        float ngv[4];
#pragma unroll
        for (int d = 0; d < 4; ++d) ngv[d] = NG[h * 128 + 32 * d + r32] * (1.0f - LAMBDA_INIT);
        unsigned o0w[2][16];
#pragma unroll
        for (int r = 0; r < 16; ++r)
#pragma unroll
            for (int dd = 0; dd < 2; ++dd) o0w[dd][r] = __hip_atomic_load(o0s + (dd * 16 + r) * 64, __ATOMIC_RELAXED, __HIP_MEMORY_SCOPE_AGENT);
#pragma unroll
        for (int r = 0; r < 16; ++r) { const float il = scr[crow(r, hi)]; float x[4]; float q2 = 0.f;
#pragma unroll
            for (int d = 0; d < 4; d += 2) { const unsigned w = o0w[d >> 1][r];
                x[d] = __uint_as_float(w << 16) - lam * (o[d][r] * il); x[d + 1] = __uint_as_float(w & 0xffff0000u) - lam * (o[d + 1][r] * il); q2 += x[d] * x[d] + x[d + 1] * x[d + 1]; }
            q2 += __shfl_xor(q2, 1); q2 += __shfl_xor(q2, 2); q2 += __shfl_xor(q2, 4); q2 += __shfl_xor(q2, 8); q2 += __shfl_xor(q2, 16);
            const float rn = rsqrtf(q2 * (1.0f / 128.0f) + 1e-6f); const size_t row = rowb + qw0 + crow(r, hi);
#pragma unroll
            for (int d = 0; d < 4; ++d) OB[row * 512 + h * 128 + 32 * d + r32] = f2bf(x[d] * rn * ngv[d]); }
    }
}
DEVINL void moe_cvt_item(const Args& a, unsigned char* ws, LAS unsigned char* lds, int item) {
    const int tid = opaque_tid(), lane = tid & 63, wave = tid >> 6;
    constexpr int I_GU = (DM / 64) * (2048 / 64), I_D = (DFF / 64) * (DM / 64);
    for (int t = 0; t < 6; ++t) { int r = item * 48 + t * 8 + wave;
        if (r < NEXP * I_GU) { const int e = r / I_GU; transpose_item_f8<true>(a.in[13] + (size_t)e * DM * 2048, DM, 2048, (unsigned char*)(ws + OFF_WGU) + (size_t)e * 2048 * DM, r % I_GU, lane); }
        else { r -= NEXP * I_GU; const int e = r / I_D; transpose_item_f8<false>(a.in[15] + (size_t)e * DFF * DM, DFF, DM, (unsigned char*)(ws + OFF_WD) + (size_t)e * DM * DFF, r % I_D, lane); } }
}
DEVINL void attn_phase(const Args& a, unsigned char* ws, LAS unsigned char* lds, int G) {
    const bf16_t* DQ = (const bf16_t*)(ws + OFF_DQ); const bf16_t* DK = (const bf16_t*)(ws + OFF_DK); const bf16_t* DV = (const bf16_t*)(ws + OFF_DV); bf16_t* OB = (bf16_t*)(ws + OFF_OB);
    const float lam = ((const float*)(ws + OFF_SMALL))[512]; const float* NG = a.in[5];
    unsigned* ctlx = (unsigned*)(ws + CTLX_OFF);
    LAS unsigned* qslot = (LAS unsigned*)(lds + LDSCTL_OFF + 256);
    for (;;) {
        __syncthreads();
        if (threadIdx.x == 0) *qslot = __hip_atomic_fetch_add(ctlx + 64, 1u, __ATOMIC_RELAXED, __HIP_MEMORY_SCOPE_AGENT);
        __syncthreads();
        const unsigned idx = *qslot;
        if (idx >= 1536u) break;
        if (idx % 3u == 2u) { moe_cvt_item(a, ws, lds, (int)(idx / 3u)); continue; }
        const unsigned it = idx - (idx + 1u) / 3u;
        const int j = (int)(it >> 9), ord = ATT_ORDER[(it >> 3) & 63], b = (int)(it & 7), h = ord >> 4, qb = ord & 15;
        attn_unit(b, h, qb, j, DQ, DK, DV, OB, (unsigned*)(ws + OFF_OJ), ctlx, NG, lam, lds);
    }
}

constexpr int HG_PQ = 272, HG_PT = 144, HG_PV = 320, HG_PS = 272;
constexpr int HG_QD = 0, HG_KI = HG_QD + 64 * HG_PQ, HG_KDT = HG_KI + 64 * HG_PQ, HG_VT = HG_KDT + 128 * HG_PT, HG_ST = HG_VT + 64 * HG_PV, HG_DVEC = HG_ST + 128 * HG_PS, HG_SEG = HG_DVEC + 512, HG_END = HG_SEG + 2048;
static_assert(HG_END + 1024 <= RING_BYTES_C, "hgrn LDS");
constexpr size_t OFF_DTOT = OFF_SMALL + 128 * 1024;
template <bool WITH_OUT>
DEVINL void hgrn_unit(int unit, const bf16_t* QA, const _Float16* LF, const bf16_t* HV, const bf16_t* HGp, const float* NG, bf16_t* OAp, float* U, float* DTOT, LAS unsigned char* lds) {
    int tid_ = threadIdx.x; asm volatile("" : "+v"(tid_));
    const int tid = tid_, lane = tid & 63, wid = __builtin_amdgcn_readfirstlane(tid >> 6), r32 = lane & 31, hi = lane >> 5, tb = wid >> 2, vb = wid & 3;
    const int kel = tid & 127, seg = tid >> 7;
    const int bh = unit >> 3, sc = unit & 7, b = bh >> 2, h = bh & 3;
    const size_t tok0 = (size_t)b * SEQ + (size_t)sc * 512;
    LAS float* dvec = (LAS float*)(lds + HG_DVEC); LAS float* segt = (LAS float*)(lds + HG_SEG); LAS float* ssq = (LAS float*)(lds + HG_END);
    f32x16 st[2];
#pragma unroll
    for (int i = 0; i < 2; ++i)
#pragma unroll
        for (int r = 0; r < 16; ++r) st[i][r] = 0.f;
    if (WITH_OUT && sc > 0) {
        f32x4 un[2][4], dn[2][4];
#define HG_LDUD(UJ) do { _Pragma("unroll") for (int i = 0; i < 2; ++i) _Pragma("unroll") for (int g = 0; g < 4; ++g) { \
            un[i][g] = *(const f32x4*)(U + (((((size_t)(UJ) * 8 + wid) * 2 + i) * 4 + g) * 64 + lane) * 4); dn[i][g] = *(const f32x4*)(DTOT + (UJ) * 128 + 32 * (2 * tb + i) + 8 * g + 4 * hi); } } while (0)
        HG_LDUD(bh * 8);
        for (int jj = 0; jj < sc; ++jj) {
            f32x4 uc[2][4], dc[2][4];
#pragma unroll
            for (int i = 0; i < 2; ++i)
#pragma unroll
                for (int g = 0; g < 4; ++g) { uc[i][g] = un[i][g]; dc[i][g] = dn[i][g]; }
            { const int ujn = bh * 8 + min(jj + 1, sc - 1); HG_LDUD(ujn); }
#pragma unroll
            for (int i = 0; i < 2; ++i)
#pragma unroll
                for (int g = 0; g < 4; ++g)
#pragma unroll
                    for (int e = 0; e < 4; ++e) st[i][4 * g + e] = st[i][4 * g + e] * dc[i][g][e] + uc[i][g][e];
        }
#undef HG_LDUD
    }
    float ltot = 0.f;
    const int vkv = tid >> 4, vch = tid & 15;
    _Float16 lfh[16]; bf16_t qav[16]; u32x4 vg0, vg1; pg8::u32x2 gate[4]; f32x4 ngv[4];
#define HG_LOADS(CH) do { const size_t t0n_ = tok0 + (CH) * 64; \
        _Pragma("unroll") for (int i = 0; i < 16; ++i) lfh[i] = LF[(t0n_ + 16 * seg + i) * 512 + h * 128 + kel]; \
        if (WITH_OUT) { _Pragma("unroll") for (int i = 0; i < 16; ++i) qav[i] = QA[(t0n_ + 16 * seg + i) * 512 + h * 128 + kel]; } \
        vg0 = *(const u32x4*)(HV + (t0n_ + vkv) * 512 + h * 128 + vch * 8); vg1 = *(const u32x4*)(HV + (t0n_ + vkv + 32) * 512 + h * 128 + vch * 8); } while (0)
    HG_LOADS(0);
    if (WITH_OUT) {
#pragma unroll
        for (int g = 0; g < 4; ++g) ngv[g] = *(const f32x4*)(NG + h * 128 + 32 * vb + 8 * g + 4 * hi);
    }
    for (int ch = 0; ch < 8; ++ch) {
        const size_t t0 = tok0 + ch * 64;
        float lfv[16], cum[16], qaf[16]; float csum = 0.f;
#pragma unroll
        for (int i = 0; i < 16; ++i) { lfv[i] = (float)lfh[i]; csum += lfv[i]; cum[i] = csum; if (WITH_OUT) qaf[i] = bf2f(qav[i]); }
        *(LAS u32x4*)(lds + HG_VT + vkv * HG_PV + vch * 16) = vg0; *(LAS u32x4*)(lds + HG_VT + (vkv + 32) * HG_PV + vch * 16) = vg1;
        if (WITH_OUT) {
#pragma unroll
            for (int g = 0; g < 4; ++g) gate[g] = *(const pg8::u32x2*)(HGp + (t0 + 32 * tb + r32) * 512 + h * 128 + 32 * vb + 8 * g + 4 * hi);
        }
        HG_LOADS(min(ch + 1, 7));
        segt[seg * 128 + kel] = csum;
        if (WITH_OUT) {
#pragma unroll
            for (int i = 0; i < 2; ++i) { const int kb = 2 * tb + i;
#pragma unroll
                for (int g = 0; g < 4; ++g) { pg8::u32x2 w; w.x = cvt_pk_bf16(st[i][4 * g], st[i][4 * g + 1]); w.y = cvt_pk_bf16(st[i][4 * g + 2], st[i][4 * g + 3]);
                    *(LAS pg8::u32x2*)(lds + HG_ST + (32 * vb + r32) * HG_PS + (32 * kb + 8 * g + 4 * hi) * 2) = w; } }
        }
        __syncthreads();
        float off = 0.f, blast = 0.f;
#pragma unroll
        for (int s2 = 0; s2 < 4; ++s2) { const float v = segt[s2 * 128 + kel]; blast += v; if (s2 < seg) off += v; }
        float kd[16];
#pragma unroll
        for (int i = 0; i < 16; ++i) { const float bc = off + cum[i]; const float kk = 1.0f - __expf(lfv[i]);
            if (WITH_OUT) { const int t = 16 * seg + i; const float qa = qaf[i];
                *(LAS bf16_t*)(lds + HG_QD + t * HG_PQ + kel * 2) = f2bf(qa * __expf(bc)); *(LAS bf16_t*)(lds + HG_KI + t * HG_PQ + kel * 2) = f2bf(kk * __expf(fminf(-bc, 80.0f))); }
            kd[i] = kk * __expf(blast - bc); }
        { u32x4 w0, w1; w0.x = cvt_pk_bf16(kd[0], kd[1]); w0.y = cvt_pk_bf16(kd[2], kd[3]); w0.z = cvt_pk_bf16(kd[4], kd[5]); w0.w = cvt_pk_bf16(kd[6], kd[7]);
          w1.x = cvt_pk_bf16(kd[8], kd[9]); w1.y = cvt_pk_bf16(kd[10], kd[11]); w1.z = cvt_pk_bf16(kd[12], kd[13]); w1.w = cvt_pk_bf16(kd[14], kd[15]);
          *(LAS u32x4*)(lds + HG_KDT + kel * HG_PT + seg * 32) = w0; *(LAS u32x4*)(lds + HG_KDT + kel * HG_PT + seg * 32 + 16) = w1; }
        if (seg == 0) { dvec[kel] = __expf(blast); ltot += blast; }
        __syncthreads();
        float ofin[16];
        bf16x8 vf[4];
#pragma unroll
        for (int s4 = 0; s4 < 4; ++s4) { LAS const unsigned char* vp = lds + HG_VT + (16 * s4 + 4 * hi + ((lane & 15) >> 2)) * HG_PV + 64 * vb + ((lane >> 4) & 1) * 32 + (lane & 3) * 8;
            const s16x4_t lo = lds_tr16(vp), hh = lds_tr16(vp + 8 * HG_PV); vf[s4] = (bf16x8){lo[0], lo[1], lo[2], lo[3], hh[0], hh[1], hh[2], hh[3]}; }
        if (WITH_OUT) {
            bf16x8 qd[8];
#pragma unroll
            for (int ks = 0; ks < 8; ++ks) qd[ks] = *(LAS const bf16x8*)(lds + HG_QD + (32 * tb + r32) * HG_PQ + (16 * ks + 8 * hi) * 2);
            f32x16 oacc;
#pragma unroll
            for (int r = 0; r < 16; ++r) oacc[r] = 0.f;
#pragma unroll
            for (int ks = 0; ks < 8; ++ks) { const bf16x8 sf = *(LAS const bf16x8*)(lds + HG_ST + (32 * vb + r32) * HG_PS + (16 * ks + 8 * hi) * 2);
                oacc = __builtin_amdgcn_mfma_f32_32x32x16_bf16(sf, qd[ks], oacc, 0, 0, 0); }
#pragma unroll
            for (int sb = 0; sb < 2; ++sb) {
                if (sb <= tb) {
                    f32x16 at;
#pragma unroll
                    for (int r = 0; r < 16; ++r) at[r] = 0.f;
#pragma unroll
                    for (int ks = 0; ks < 8; ++ks) { const bf16x8 kf = *(LAS const bf16x8*)(lds + HG_KI + (32 * sb + r32) * HG_PQ + (16 * ks + 8 * hi) * 2);
                        at = __builtin_amdgcn_mfma_f32_32x32x16_bf16(kf, qd[ks], at, 0, 0, 0); }
                    if (sb == tb) {
#pragma unroll
                        for (int r = 0; r < 16; ++r) if (crow(r, hi) > r32) at[r] = 0.f;
                    }
#pragma unroll
                    for (int s2 = 0; s2 < 2; ++s2) { u32x4 w; w.x = cvt_pk_bf16(at[8 * s2], at[8 * s2 + 1]); w.y = cvt_pk_bf16(at[8 * s2 + 2], at[8 * s2 + 3]); w.z = cvt_pk_bf16(at[8 * s2 + 4], at[8 * s2 + 5]); w.w = cvt_pk_bf16(at[8 * s2 + 6], at[8 * s2 + 7]);
                        oacc = __builtin_amdgcn_mfma_f32_32x32x16_bf16(vf[2 * sb + s2], __builtin_bit_cast(bf16x8, w), oacc, 0, 0, 0); }
                }
            }
            { float q2 = 0.f;
#pragma unroll
              for (int r = 0; r < 16; ++r) q2 += oacc[r] * oacc[r];
              q2 += __shfl_xor(q2, 32);
              if (hi == 0) ssq[(32 * tb + r32) * 4 + vb] = q2; }
#pragma unroll
            for (int r = 0; r < 16; ++r) ofin[r] = oacc[r];
        }
#pragma unroll
        for (int i = 0; i < 2; ++i) { const int kb = 2 * tb + i;
#pragma unroll
            for (int r = 0; r < 16; ++r) st[i][r] *= dvec[32 * kb + crow(r, hi)];
#pragma unroll
            for (int s4 = 0; s4 < 4; ++s4) { LAS const unsigned char* kp = lds + HG_KDT + (32 * kb + r32) * HG_PT + (16 * s4 + 4 * hi) * 2;
                const pg8::u32x2 a0 = *(LAS const pg8::u32x2*)kp, a1 = *(LAS const pg8::u32x2*)(kp + 16);
                const u32x4 aw = (u32x4){a0.x, a0.y, a1.x, a1.y};
                st[i] = __builtin_amdgcn_mfma_f32_32x32x16_bf16(__builtin_bit_cast(bf16x8, aw), vf[s4], st[i], 0, 0, 0); } }
        __syncthreads();
        if (WITH_OUT) {
            const f32x4 q4 = *(LAS const f32x4*)(ssq + (32 * tb + r32) * 4); const float rn = rsqrtf(((q4[0] + q4[1]) + (q4[2] + q4[3])) * (1.0f / 128.0f) + 1e-6f);
#pragma unroll
            for (int g = 0; g < 4; ++g) { const f32x4 gn = ngv[g]; const pg8::u32x2 gw = gate[g];
                const float g0 = __uint_as_float(gw.x << 16), g1 = __uint_as_float(gw.x & 0xffff0000u), g2 = __uint_as_float(gw.y << 16), g3 = __uint_as_float(gw.y & 0xffff0000u);
                pg8::u32x2 w; w.x = cvt_pk_bf16(ofin[4 * g] * rn * gn[0] * g0, ofin[4 * g + 1] * rn * gn[1] * g1); w.y = cvt_pk_bf16(ofin[4 * g + 2] * rn * gn[2] * g2, ofin[4 * g + 3] * rn * gn[3] * g3);
                *(pg8::u32x2*)(OAp + (t0 + 32 * tb + r32) * 512 + h * 128 + 32 * vb + 8 * g + 4 * hi) = w; }
        }
    }
#undef HG_LOADS
    if (!WITH_OUT) {
#pragma unroll
        for (int i = 0; i < 2; ++i)
#pragma unroll
            for (int g = 0; g < 4; ++g) *(f32x4*)(U + (((((size_t)unit * 8 + wid) * 2 + i) * 4 + g) * 64 + lane) * 4) = (f32x4){st[i][4 * g], st[i][4 * g + 1], st[i][4 * g + 2], st[i][4 * g + 3]};
        if (seg == 0) DTOT[unit * 128 + kel] = __expf(ltot);
    }
}

DEVINL void phase_ln1_router(const Args& a, unsigned char* ws, LAS unsigned char* lds, int G) {
    const int tid = opaque_tid(), lane = tid & 63, wid = tid >> 6;
    const float* rw = a.in[11]; const float* rb = a.in[12];
    bf16_t* H1 = (bf16_t*)(ws + OFF_H1); bf16_t* H1B = (bf16_t*)(ws + OFF_H1B); int* counts = (int*)(ws + CTL_OFF);
    int* ltok = (int*)(ws + OFF_LTOK); float* lw = (float*)(ws + OFF_LW); int* toke = (int*)(ws + OFF_TOKE); int* tokr = (int*)(ws + OFF_TOKR);
    LAS unsigned char* rwl = lds;
    LAS float* tl = (LAS float*)(lds + LDSCTL_OFF + 64) + wid * 528;
    __syncthreads();
#pragma unroll 2
    for (int ps = 0; ps < 8; ++ps) { const int e = tid & 31, kb = ps * 16 + (tid >> 5);
        float v[8], l[8]; unsigned wh[4], wl[4];
#pragma unroll
        for (int j = 0; j < 8; ++j) v[j] = rw[(8 * kb + j) * 32 + e];
#pragma unroll
        for (int j = 0; j < 4; ++j) { wh[j] = cvt_pk_bf16(v[2 * j], v[2 * j + 1]); l[2 * j] = v[2 * j] - __uint_as_float(wh[j] << 16); l[2 * j + 1] = v[2 * j + 1] - __uint_as_float(wh[j] & 0xffff0000u); }
#pragma unroll
        for (int j = 0; j < 4; ++j) wl[j] = cvt_pk_bf16(l[2 * j], l[2 * j + 1]);
        const int off = ((((e >> 4) * 32 + (kb >> 2)) * 4 + (kb & 3)) * 16 + (e & 15)) * 16;
        *(LAS u32x4*)(rwl + off) = (u32x4){wh[0], wh[1], wh[2], wh[3]}; *(LAS u32x4*)(rwl + 65536 + off) = (u32x4){wl[0], wl[1], wl[2], wl[3]}; }
    __syncthreads();
    const int i16 = lane & 15, kq = lane >> 4;
    LAS int* hist = (LAS int*)(lds + LDSCTL_OFF + 64 + 8 * 528 * 4); LAS int* wbase = hist + 32;
    if (tid < 32) hist[tid] = 0;
    __syncthreads();
    const int nrounds = (NTOK / 16 + G * 8 - 1) / (G * 8);
    for (int round = 0; round < nrounds; ++round) {
        const int tile = round * G * 8 + blockIdx.x * 8 + wid; const bool active = tile < NTOK / 16;
        int ti[4] = {0, 0, 0, 0}, lrank[4] = {0, 0, 0, 0}; float wsn[4] = {0.f, 0.f, 0.f, 0.f};
        const int row0 = tile * 16;
        if (active) {
        asm volatile("s_waitcnt vmcnt(0)" ::: "memory");
        f32x4 acc0 = (f32x4){0.f, 0.f, 0.f, 0.f}, acc1 = (f32x4){0.f, 0.f, 0.f, 0.f};
        const bf16_t* hrow = H1 + (size_t)(row0 + i16) * DM + 8 * kq;
        LAS const unsigned char* bp0 = rwl + (kq * 16 + i16) * 16;
        bf16x8 afr[32];
#pragma unroll
        for (int st = 0; st < 32; ++st) afr[st] = *(const bf16x8*)(hrow + 32 * st);
#pragma unroll
        for (int st = 0; st < 32; ++st) {
            const bf16x8 af = afr[st];
            LAS const unsigned char* bp = bp0 + st * 1024;
            const bf16x8 b0h = *(LAS const bf16x8*)bp, b1h = *(LAS const bf16x8*)(bp + 32768), b0l = *(LAS const bf16x8*)(bp + 65536), b1l = *(LAS const bf16x8*)(bp + 65536 + 32768);
            acc0 = __builtin_amdgcn_mfma_f32_16x16x32_bf16(af, b0h, acc0, 0, 0, 0); acc1 = __builtin_amdgcn_mfma_f32_16x16x32_bf16(af, b1h, acc1, 0, 0, 0);
            acc0 = __builtin_amdgcn_mfma_f32_16x16x32_bf16(af, b0l, acc0, 0, 0, 0); acc1 = __builtin_amdgcn_mfma_f32_16x16x32_bf16(af, b1l, acc1, 0, 0, 0); }
        const float rb0 = rb[i16], rb1 = rb[16 + i16];
#pragma unroll
        for (int rg = 0; rg < 4; ++rg) { tl[(4 * kq + rg) * 33 + i16] = acc0[rg] + rb0; tl[(4 * kq + rg) * 33 + 16 + i16] = acc1[rg] + rb1; }
        asm volatile("s_waitcnt lgkmcnt(0)" ::: "memory");
        if (lane < 16) {
            const int row = row0 + lane;
            float lg[32];
#pragma unroll
            for (int e = 0; e < 32; ++e) lg[e] = tl[lane * 33 + e];
            unsigned taken = 0u; float tv[4];
#pragma unroll
            for (int k = 0; k < 4; ++k) { float best = -INFINITY; int bi = 0;
#pragma unroll
                for (int e = 0; e < 32; ++e) { const bool ok = !((taken >> e) & 1u) && lg[e] > best; best = ok ? lg[e] : best; bi = ok ? e : bi; }
                taken |= 1u << bi; tv[k] = best; ti[k] = bi; }
            float den = 0.f;
#pragma unroll
            for (int k = 0; k < 4; ++k) { wsn[k] = expf(tv[k] - tv[0]); den += wsn[k]; }
#pragma unroll
            for (int k = 0; k < 4; ++k) { wsn[k] /= den; lrank[k] = __hip_atomic_fetch_add((int*)(hist + ti[k]), 1, __ATOMIC_RELAXED, __HIP_MEMORY_SCOPE_WORKGROUP); }
        }
        }
        __syncthreads();
        if (tid < 32) { const int c = hist[tid]; wbase[tid] = c ? atomicAdd(&counts[tid], c) : 0; }
        __syncthreads();
        if (active && lane < 16) { const int row = row0 + lane;
#pragma unroll
            for (int k = 0; k < 4; ++k) { const int e = ti[k]; const int rank = wbase[e] + lrank[k];
                ltok[(size_t)e * NTOK + rank] = row; lw[row * 4 + k] = wsn[k]; toke[row * 4 + k] = e; tokr[row * 4 + k] = rank; } }
        __syncthreads();
        if (tid < 32) hist[tid] = 0;
        __syncthreads();
    }
}
#ifndef LN2_NR
#define LN2_NR 4
#endif
DEVINL void phase_ln2(const Args& a, unsigned char* ws, int G) {
    const int tid = opaque_tid(), lane = tid & 63;
    const bf16_t* H1 = (const bf16_t*)(ws + OFF_H1); const unsigned char* Y2 = (const unsigned char*)(ws + OFF_Y2); const int* counts = (const int*)(ws + CTL_OFF);
    const int* toke = (const int*)(ws + OFF_TOKE); const int* tokr = (const int*)(ws + OFF_TOKR); float* out = a.out; const float* lwt = (const float*)(ws + OFF_LW);
    const f32x4* g4 = (const f32x4*)a.in[17] + lane; const f32x4* b4 = (const f32x4*)a.in[18] + lane;
    f32x4 gv[4], bv[4];
#pragma unroll
    for (int j = 0; j < 4; ++j) { gv[j] = g4[64 * j]; bv[j] = b4[64 * j]; }
    int pad = lane < 32 ? ((counts[lane] + 255) >> 8) : 0; int incl = pad;
    for (int d = 1; d < 32; d <<= 1) { const int t = __shfl_up(incl, d); if (lane >= d) incl += t; }
    const int excl = (incl - pad) * 256;
    const int NW = G * 8;
    int4 ten[LN2_NR], trn[LN2_NR]; f32x4 twn[LN2_NR];
    { const int rf = blockIdx.x * 8 + (tid >> 6);
#pragma unroll
      for (int u = 0; u < LN2_NR; ++u) { const int r = rf + u * NW < NTOK ? rf + u * NW : (rf < NTOK ? rf : 0); ten[u] = *(const int4*)(toke + r * 4); trn[u] = *(const int4*)(tokr + r * 4); twn[u] = *(const f32x4*)(lwt + r * 4); } }
    for (int row0 = blockIdx.x * 8 + (tid >> 6); row0 < NTOK; row0 += LN2_NR * NW) {
        int rows[LN2_NR];
#pragma unroll
        for (int u = 0; u < LN2_NR; ++u) rows[u] = row0 + u * NW;
        int4 te[LN2_NR], tr[LN2_NR]; f32x4 tw[LN2_NR];
#pragma unroll
        for (int u = 0; u < LN2_NR; ++u) { te[u] = ten[u]; tr[u] = trn[u]; tw[u] = twn[u]; }
        { const int rf = row0 + LN2_NR * NW;
#pragma unroll
          for (int u = 0; u < LN2_NR; ++u) { const int r = rf + u * NW < NTOK ? rf + u * NW : row0; ten[u] = *(const int4*)(toke + r * 4); trn[u] = *(const int4*)(tokr + r * 4); twn[u] = *(const f32x4*)(lwt + r * 4); } }
        f32x4 y[LN2_NR][4]; unsigned yv[LN2_NR][4][4];
#pragma unroll
        for (int u = 0; u < LN2_NR; ++u) { const int r = rows[u] < NTOK ? rows[u] : row0;
            size_t arow[4];
            arow[0] = (size_t)(__shfl(excl, te[u].x) + tr[u].x); arow[1] = (size_t)(__shfl(excl, te[u].y) + tr[u].y); arow[2] = (size_t)(__shfl(excl, te[u].z) + tr[u].z); arow[3] = (size_t)(__shfl(excl, te[u].w) + tr[u].w);
#pragma unroll
            for (int j = 0; j < 4; ++j) { { const pg8::u32x2 hw = ((const pg8::u32x2*)(H1 + (size_t)r * DM))[lane + 64 * j]; y[u][j] = (f32x4){__uint_as_float(hw.x << 16), __uint_as_float(hw.x & 0xffff0000u), __uint_as_float(hw.y << 16), __uint_as_float(hw.y & 0xffff0000u)}; }
#pragma unroll
                for (int k = 0; k < 4; ++k) yv[u][k][j] = ((const unsigned*)(Y2 + arow[k] * DM))[lane + 64 * j]; } }
#pragma unroll
        for (int u = 0; u < LN2_NR; ++u) { if (rows[u] >= NTOK) continue;
            float s_ = 0.f;
#pragma unroll
            for (int j = 0; j < 4; ++j) { f32x4 v = y[u][j] * DN_ALPHA;
#pragma unroll
                for (int k = 0; k < 4; ++k) { const unsigned w = yv[u][k][j]; const float tk = tw[u][k] * (1.0f / Y2_SCALE); const pg8::f32x2 lo = __builtin_amdgcn_cvt_pk_f32_fp8((int)w, false), hh = __builtin_amdgcn_cvt_pk_f32_fp8((int)w, true);
                    v[0] += tk * lo.x; v[1] += tk * lo.y; v[2] += tk * hh.x; v[3] += tk * hh.y; }
                y[u][j] = v; s_ += (v[0] + v[1]) + (v[2] + v[3]); }
            const float mean = wave_sum(s_) * (1.0f / 1024.0f); float q = 0.f;
#pragma unroll
            for (int j = 0; j < 4; ++j) { y[u][j] = y[u][j] - mean; q += (y[u][j][0] * y[u][j][0] + y[u][j][1] * y[u][j][1]) + (y[u][j][2] * y[u][j][2] + y[u][j][3] * y[u][j][3]); }
            const float rstd = rsqrtf(wave_sum(q) * (1.0f / 1024.0f) + 1e-5f);
#pragma unroll
            for (int j = 0; j < 4; ++j) ((f32x4*)(out + (size_t)rows[u] * DM))[lane + 64 * j] = y[u][j] * rstd * gv[j] + bv[j]; }
    }
}
DEVINL int build_tile_table(LAS unsigned char* ldsctl, const int* counts) {
    LAS int* pre = (LAS int*)(ldsctl + LC_PRE); LAS int* tab = (LAS int*)(ldsctl + LC_TAB);
    __syncthreads();
    if (threadIdx.x == 0) { int s = 0; for (int e = 0; e < NEXP; ++e) { pre[e] = s; s += (counts[e] + 255) >> 8; } pre[NEXP] = s; }
    __syncthreads();
    const int nT = pre[NEXP];
    for (int t = threadIdx.x; t < nT; t += 512) { int e = 0; for (int k = 1; k < NEXP; ++k) if (pre[k] <= t) e = k; tab[t] = e | ((t - pre[e]) << 8); }
    __syncthreads();
    return nT;
}

__global__ void __launch_bounds__(512, 2) mk_fwd(Args args) {
    extern __shared__ __attribute__((aligned(16))) unsigned char lds_raw[];
    LAS unsigned char* lds = (LAS unsigned char*)lds_raw;
    LAS unsigned char* ldsctl = lds + LDSCTL_OFF;
    const int tid = threadIdx.x; const int G = gridDim.x;
    unsigned char* ws = args.ws;
    for (int u = tid; u < (LDS_BYTES - LDSCTL_OFF) / 4; u += 512) ((LAS unsigned*)ldsctl)[u] = 0u;
    __syncthreads();
    XcdBarrier bar = xcd_barrier_post((unsigned*)(ws + CTL_OFF + CTL_BAR) + args.li * XCD_BAR_WORDS, (volatile LAS unsigned*)(ldsctl + LC_MISC) + 8);
    const int lo = args.ph_lo, hi = args.ph_hi;
    const int* counts = (const int*)(ws + CTL_OFF);
#ifndef PHMASK
#define PHMASK 0xFFFF
#endif
#define IN(k) (((PHMASK >> (k)) & 1) && lo <= (k) && (k) < hi)
#define BOTH(k) (IN(k) && IN((k) + 1))
#define GRID_BAR() xcd_barrier(bar)

    if (IN(PH_PRO)) { phase_prologue(args, ws, lds, G); if (BOTH(PH_PRO)) GRID_BAR(); }
    if (IN(PH_INPROJ)) {
        { pg8::PlainOrder<1024> S{(const char*)(ws + OFF_XB), (const char*)(ws + OFF_WIN), NTOK / 256, 12, G, (int)blockIdx.x};
          EpiInproj<false> E{ws, (const float*)(ws + OFF_SMALL)};
          pg8::gemm_phase<1024, false>(lds, S, E); }
        { pg8::PlainOrder<512> S{(const char*)(ws + OFF_XB8), (const char*)(ws + OFF_WIN8), NTOK / 256, 10, G, (int)blockIdx.x};
          EpiInproj<true> E{ws, (const float*)(ws + OFF_SMALL)};
          pg8::gemm_phase<512, false, EpiInproj<true>, pg8::PlainOrder<512>, true>(lds, S, E); }
        if (BOTH(PH_INPROJ)) GRID_BAR();
    }
    if (IN(PH_HGA)) {
        for (int u = blockIdx.x; u < 256; u += G) hgrn_unit<false>(u, (const bf16_t*)(ws + OFF_QA), (const _Float16*)(ws + OFF_LF), (const bf16_t*)(ws + OFF_HV), (const bf16_t*)(ws + OFF_HG), args.in[3], (bf16_t*)(ws + OFF_OA), (float*)(ws + OFF_U), (float*)(ws + OFF_DTOT), lds);
        if (BOTH(PH_HGA)) GRID_BAR();
    }
    if (IN(PH_ATT)) {
        for (int u = blockIdx.x; u < 256; u += G) hgrn_unit<true>(u, (const bf16_t*)(ws + OFF_QA), (const _Float16*)(ws + OFF_LF), (const bf16_t*)(ws + OFF_HV), (const bf16_t*)(ws + OFF_HG), args.in[3], (bf16_t*)(ws + OFF_OA), (float*)(ws + OFF_U), (float*)(ws + OFF_DTOT), lds);
        __syncthreads();
        attn_phase(args, ws, lds, G);
        __syncthreads();
        if (BOTH(PH_ATT)) GRID_BAR();
    }
    if (IN(PH_BRANCH)) {
        { BranchOrder S{(const char*)(ws + OFF_OA), (const char*)(ws + OFF_OB), (const char*)(ws + OFF_WA), (const char*)(ws + OFF_WB), NTOK / 256, DM / 256, G, (int)blockIdx.x};
          EpiBranchChain E{(const bf16_t*)(ws + OFF_GA), (const bf16_t*)(ws + OFF_GB), (bf16_t*)(ws + OFF_MERGED)};
          pg8::gemm_phase<512, false>(lds, S, E); }
        if (BOTH(PH_BRANCH)) GRID_BAR();
    }
    if (IN(PH_OUT)) {
        pg8::PlainOrder<1024> S{(const char*)(ws + OFF_MERGED), (const char*)(ws + OFF_WOUT), NTOK / 256, DM / 256, G, (int)blockIdx.x};
        { LAS float* gl = (LAS float*)(lds + LDSCTL_OFF + 64 + 10368);
          for (int i = tid; i < 2048; i += 512) gl[i] = i < 1024 ? args.in[9][i] : args.in[10][i - 1024];
          __syncthreads(); }
        EpiOutLn E{(const bf16_t*)(ws + OFF_XB), args.in[9], args.in[10], (bf16_t*)(ws + OFF_H1), (unsigned char*)(ws + OFF_H1B), (unsigned long long*)(ws + OFF_OJ), (unsigned*)(ws + CTL_OFF + 20480), (unsigned*)(ws + CTL_OFF + 53248), lds + LDSCTL_OFF + 64};
        pg8::gemm_phase<1024, false>(lds, S, E);
        if (BOTH(PH_OUT)) GRID_BAR();
    }
    if (IN(PH_LN1)) { phase_ln1_router(args, ws, lds, G); if (BOTH(PH_LN1)) GRID_BAR(); }
    if (IN(PH_GU)) {
        const int nT = build_tile_table(ldsctl, counts);
        MoeOrder<512, true> S{(const LAS int*)(ldsctl + LC_TAB), nT, 8, G, (int)blockIdx.x, (const char*)(ws + OFF_H1B), (const char*)(ws + OFF_WGU), counts, (const int*)(ws + OFF_LTOK), (const LAS unsigned short*)(ldsctl + 4096)};
        {
            LAS unsigned short* tokl = (LAS unsigned short*)(ldsctl + 4096);
#pragma unroll
            for (int p = 0; p < 9; ++p) { const int i = 2 * p + (tid >> 8); Unit u;
                if (S.next(i, u)) { const int r = u.r0 + (tid & 255); const int cnt = counts[u.e]; tokl[i * 256 + (tid & 255)] = (unsigned short)(r < cnt ? S.ltok[(size_t)u.e * NTOK + r] : 0); } }
            __syncthreads();
        }
        EpiGU8 E{args.in[14], (unsigned char*)(ws + OFF_ACT)};
        pg8::gemm_phase<512, true, EpiGU8, MoeOrder<512, true>, true>(lds, S, E);
        if (BOTH(PH_GU)) GRID_BAR();
    }
    if (IN(PH_DOWN)) {
        const int nT = build_tile_table(ldsctl, counts);
        MoeOrder<512, false> S{(const LAS int*)(ldsctl + LC_TAB), nT, 4, G, (int)blockIdx.x, (const char*)(ws + OFF_ACT), (const char*)(ws + OFF_WD), counts, nullptr, nullptr};
        EpiDown8 E{args.in[16], (unsigned char*)(ws + OFF_Y2)};
        pg8::gemm_phase<512, false, EpiDown8, MoeOrder<512, false>, true>(lds, S, E);
        if (BOTH(PH_DOWN)) GRID_BAR();
    }
    if (IN(PH_LN2)) { phase_ln2(args, ws, G); }
#undef IN
#undef BOTH
#undef GRID_BAR
}

static void launch_mk(const Args& base, int lo, int hi, int li, int grid, hipStream_t stream) {
    Args a = base; a.ph_lo = lo; a.ph_hi = hi; a.li = li; a.pad = 0;
    hipLaunchKernelGGL(mk_fwd, dim3(grid), dim3(512), LDS_BYTES, stream, a);
}

extern "C" void kernel_launch(void* const* d_in, const int* in_sizes, int n_in, void* d_out, int out_size, void* d_ws, size_t ws_size, hipStream_t stream) {
    if (ws_size < WS_NEED || n_in < 19) return;
    static int grid = 0;
    if (grid == 0) {
        int dev = 0, cus = 0;
        if (hipGetDevice(&dev) != hipSuccess || hipDeviceGetAttribute(&cus, hipDeviceAttributeMultiprocessorCount, dev) != hipSuccess || cus <= 0) cus = 256;
        (void)hipFuncSetAttribute((const void*)mk_fwd, hipFuncAttributeMaxDynamicSharedMemorySize, LDS_BYTES);
        (void)hipGetLastError();
        grid = cus;
    }
    Args base{}; for (int i = 0; i < 19; ++i) base.in[i] = (const float*)d_in[i]; base.out = (float*)d_out; base.ws = (unsigned char*)d_ws;
    (void)hipMemsetAsync((unsigned char*)d_ws + CTL_OFF, 0, CTL_BYTES, stream);
    launch_mk(base, PH_PRO, PH_END, 0, grid, stream);
}
```
